# Optimizing an MI355X kernel written in HIP

```python
import jax, jax.numpy as jnp
from jax import lax
import numpy as np

D_MODEL = 1024
BATCH = 32
SEQ = 2048
DEPTH = 1
DEC_BATCH = 16
DEC_SEQ = 2048
PAST_LEN = 128

N_MEM = 256
GRID_W = 64
HEAD_DIM = 64
A_GROUPS = ((128, 1), (512, 4), (2048, 16))
A_N_GROUPS = 3
A_HEADS = 8
A_WIDTH = A_HEADS * HEAD_DIM
B_HEADS = 8
B_WIDTH = B_HEADS * HEAD_DIM
NA_ROWS = 8
NA_COLS = 16
NA_Q_COLS = 16
NA_K_COLS = 32
M_HEADS = 4
M_HEAD_DIM = 128
M_WIDTH = M_HEADS * M_HEAD_DIM
N_BRANCH = 3
SPLITS = (A_N_GROUPS * A_WIDTH, A_N_GROUPS * A_WIDTH, A_N_GROUPS * A_WIDTH, A_WIDTH,
          B_WIDTH, B_WIDTH, B_WIDTH, B_WIDTH, M_WIDTH, M_WIDTH, N_BRANCH * D_MODEL)
D_IN = sum(SPLITS)
RMS_EPS = 1e-6
NEG_INF = -1e30

kernel_name = 'hybrid_dilated_neighbourhood_memory_encoder'


def _rmsnorm(x, g):
    x32 = x.astype(jnp.float32)
    y = x32 * lax.rsqrt(jnp.mean(x32 * x32, axis=-1, keepdims=True) + RMS_EPS)
    return (y * g.astype(jnp.float32)).astype(x.dtype)


def _dilated_group(q, k, v, window, dilation, slopes):
    b, s, h, dh = q.shape
    reach = window // (2 * dilation)
    L = s // dilation
    nb = -(-L // reach)
    Lp = nb * reach

    def sub(t):
        return t.reshape(b, L, dilation, h, dh).transpose(0, 2, 1, 3, 4)

    qb = jnp.pad(sub(q), ((0, 0), (0, 0), (0, Lp - L), (0, 0), (0, 0))).reshape(b, dilation, nb, reach, h, dh)

    def kv_blocks(t):
        tp = jnp.pad(sub(t), ((0, 0), (0, 0), (reach, Lp - L + reach), (0, 0), (0, 0)))
        tp = tp.reshape(b, dilation, nb + 2, reach, h, dh)
        return jnp.concatenate([tp[:, :, 0:nb], tp[:, :, 1:nb + 1], tp[:, :, 2:nb + 2]], axis=3)

    kb, vb = kv_blocks(k), kv_blocks(v)
    scores = jnp.einsum('bdnqhe,bdnkhe->bhdnqk', qb, kb) * (dh ** -0.5)
    qi = np.arange(reach)[:, None]
    ki = np.arange(3 * reach)[None, :]
    off = ki - reach - qi
    kpos = np.arange(nb)[:, None, None] * reach + ki[None] - reach
    valid = (np.abs(off) <= reach)[None] & (kpos >= 0) & (kpos < L)
    dist = (np.abs(off) * dilation).astype(np.float32)
    alibi = -slopes[:, None, None] * dist
    sc = jnp.where(valid[None, None, None], scores + alibi[None, :, None, None], NEG_INF)
    m = jnp.max(sc, axis=-1, keepdims=True)
    p = jnp.exp(sc - m)
    l = jnp.sum(p, axis=-1)
    o = jnp.einsum('bhdnqk,bdnkhe->bhdnqe', p, vb)

    def unsub(t):
        rest = t.shape[5:]
        t = t.reshape(b, h, dilation, Lp, *rest)[:, :, :, :L]
        t = t.transpose((0, 3, 2, 1) + tuple(range(4, t.ndim)))
        return t.reshape(b, s, h, *rest)

    return unsub(m[..., 0]), unsub(l), unsub(o)


def _dilated_mixer(q, k, v):
    n_heads = A_N_GROUPS * A_HEADS
    slopes = jnp.exp2(-8.0 * jnp.arange(1, n_heads + 1, dtype=jnp.float32) / n_heads).reshape(A_N_GROUPS, A_HEADS)
    ms, ls, os_ = [], [], []
    for g, (window, dilation) in enumerate(A_GROUPS):
        m, l, o = _dilated_group(q[:, :, g], k[:, :, g], v[:, :, g], window, dilation, slopes[g])
        ms.append(m); ls.append(l); os_.append(o)
    mm = jnp.stack(ms)
    w = jnp.exp(mm - jnp.max(mm, axis=0, keepdims=True))
    num = jnp.sum(w[..., None] * jnp.stack(os_), axis=0)
    den = jnp.sum(w * jnp.stack(ls), axis=0)
    return num / den[..., None]


def _neighbourhood_attention(q, k, v, rpb):
    b, s, h, dh = q.shape
    rows = s // GRID_W
    wr = min(NA_ROWS, rows)
    n_cb = GRID_W // NA_Q_COLS
    qc = np.arange(GRID_W).reshape(n_cb, NA_Q_COLS)
    sc = np.clip(qc - NA_COLS // 2, 0, GRID_W - NA_COLS)
    kstart = np.minimum(sc[:, 0], GRID_W - NA_K_COLS)
    kc = kstart[:, None] + np.arange(NA_K_COLS)[None]
    dc = kc[:, None, :] - qc[:, :, None]
    col_valid = (kc[:, None, :] >= sc[:, :, None]) & (kc[:, None, :] < sc[:, :, None] + NA_COLS)
    dc_idx = np.clip(dc + NA_COLS - 1, 0, 2 * NA_COLS - 2)
    col_bias = rpb[:, :, dc_idx]
    kg = k.reshape(b, rows, GRID_W, h, dh)
    vg = v.reshape(b, rows, GRID_W, h, dh)
    qrows = q.reshape(b, rows, n_cb, NA_Q_COLS, h, dh).transpose(1, 0, 2, 3, 4, 5)
    scale = dh ** -0.5

    def row_fn(args):
        r, q_r = args
        r0 = jnp.clip(r - wr // 2, 0, rows - wr)
        k_r = lax.dynamic_slice_in_dim(kg, r0, wr, axis=1)[:, :, kc]
        v_r = lax.dynamic_slice_in_dim(vg, r0, wr, axis=1)[:, :, kc]
        scores = jnp.einsum('bcqhe,bwcmhe->bhcqwm', q_r, k_r) * scale
        dr_idx = r0 + jnp.arange(wr) - r + NA_ROWS - 1
        bias = jnp.take(col_bias, dr_idx, axis=1).transpose(0, 2, 3, 1, 4)
        sc_ = jnp.where(col_valid[None, None, :, :, None, :], scores + bias[None], NEG_INF)
        p = jax.nn.softmax(sc_.reshape(b, h, n_cb, NA_Q_COLS, wr * NA_K_COLS), axis=-1)
        p = p.reshape(b, h, n_cb, NA_Q_COLS, wr, NA_K_COLS)
        return jnp.einsum('bhcqwm,bwcmhe->bcqhe', p, v_r)

    out = lax.map(row_fn, (jnp.arange(rows), qrows))
    return out.transpose(1, 0, 2, 3, 4, 5).reshape(b, s, h, dh)


def _memory_attention(q, mk, mv):
    scores = jnp.einsum('bshe,bnhe->bhsn', q, mk) * (q.shape[-1] ** -0.5)
    p = jax.nn.softmax(scores, axis=-1)
    return jnp.einsum('bhsn,bnhe->bshe', p, mv)


def _layer(x, mem, g_norm, g_mem, w_in, w_mem_kv, rpb, w_pa, w_pb, w_pm, w_out):
    b, s, _ = x.shape
    f32 = jnp.float32
    h = _rmsnorm(x, g_norm)
    proj = h @ w_in
    split_points = np.cumsum(SPLITS)[:-1].tolist()
    aq, ak, av, ag, bq, bk, bv, bg, mq, mg, merge = jnp.split(proj, split_points, axis=-1)

    def heads(t, *hd):
        return t.reshape(b, t.shape[1], *hd).astype(f32)

    a_out = _dilated_mixer(heads(aq, A_N_GROUPS, A_HEADS, HEAD_DIM),
                           heads(ak, A_N_GROUPS, A_HEADS, HEAD_DIM),
                           heads(av, A_N_GROUPS, A_HEADS, HEAD_DIM))
    b_out = _neighbourhood_attention(heads(bq, B_HEADS, HEAD_DIM), heads(bk, B_HEADS, HEAD_DIM),
                                     heads(bv, B_HEADS, HEAD_DIM), rpb.astype(f32))
    mem_h = _rmsnorm(mem, g_mem)
    mk, mv = jnp.split(mem_h @ w_mem_kv, 2, axis=-1)
    m_out = _memory_attention(heads(mq, M_HEADS, M_HEAD_DIM), heads(mk, M_HEADS, M_HEAD_DIM),
                              heads(mv, M_HEADS, M_HEAD_DIM))

    branch_a = (a_out.reshape(b, s, A_WIDTH).astype(x.dtype) * jax.nn.silu(ag)) @ w_pa
    branch_b = (b_out.reshape(b, s, B_WIDTH).astype(x.dtype) * jax.nn.silu(bg)) @ w_pb
    branch_m = (m_out.reshape(b, s, M_WIDTH).astype(x.dtype) * jax.nn.silu(mg)) @ w_pm
    gates = jax.nn.sigmoid(merge).reshape(b, s, N_BRANCH, D_MODEL)
    merged = gates[:, :, 0] * branch_a + gates[:, :, 1] * branch_b + gates[:, :, 2] * branch_m
    return x + merged @ w_out


def setup_inputs(seed: int = 0) -> dict:
    key = jax.random.key(seed)
    ks = jax.random.split(key, 16)
    nrm = jax.random.normal
    f32 = jnp.float32
    return {
        'x_prompt': nrm(ks[0], (BATCH, SEQ, D_MODEL), f32),
        'x_sample': nrm(ks[1], (DEC_BATCH, DEC_SEQ, D_MODEL), f32),
        'mem_prompt': nrm(ks[2], (BATCH, N_MEM, D_MODEL), f32),
        'mem_sample': nrm(ks[3], (DEC_BATCH, N_MEM, D_MODEL), f32),
        'norm_gain': 1.0 + 0.1 * nrm(ks[4], (DEPTH, D_MODEL), f32),
        'mem_norm_gain': 1.0 + 0.1 * nrm(ks[5], (DEPTH, D_MODEL), f32),
        'w_in': nrm(ks[6], (DEPTH, D_MODEL, D_IN), f32) * D_MODEL ** -0.5,
        'w_mem_kv': nrm(ks[7], (DEPTH, D_MODEL, 2 * M_WIDTH), f32) * D_MODEL ** -0.5,
        'rpb': 0.5 * nrm(ks[8], (DEPTH, B_HEADS, 2 * NA_ROWS - 1, 2 * NA_COLS - 1), f32),
        'w_proj_a': nrm(ks[9], (DEPTH, A_WIDTH, D_MODEL), f32) * A_WIDTH ** -0.5,
        'w_proj_b': nrm(ks[10], (DEPTH, B_WIDTH, D_MODEL), f32) * B_WIDTH ** -0.5,
        'w_proj_m': nrm(ks[11], (DEPTH, M_WIDTH, D_MODEL), f32) * M_WIDTH ** -0.5,
        'w_out': nrm(ks[12], (DEPTH, D_MODEL, D_MODEL), f32) * D_MODEL ** -0.5,
        'final_norm_gain': 1.0 + 0.1 * nrm(ks[13], (D_MODEL,), f32),
    }


def reference(x_prompt, x_sample, mem_prompt, mem_sample, norm_gain, mem_norm_gain, w_in, w_mem_kv,
              rpb, w_proj_a, w_proj_b, w_proj_m, w_out, final_norm_gain):
    def trunk(x, mem):
        for i in range(DEPTH):
            x = _layer(x, mem, norm_gain[i], mem_norm_gain[i], w_in[i], w_mem_kv[i], rpb[i],
                       w_proj_a[i], w_proj_b[i], w_proj_m[i], w_out[i])
        return _rmsnorm(x, final_norm_gain)

    y_prompt = trunk(x_prompt, mem_prompt)
    y_sample = trunk(x_sample, mem_sample)
    return (y_prompt, y_sample)
```

```cpp
#include <hip/hip_runtime.h>
#include <hip/hip_cooperative_groups.h>
#include <cstdio>
#include <cstdint>
namespace cg = cooperative_groups;

#define LAS __attribute__((address_space(3)))
#define DI __device__ __forceinline__
typedef unsigned short bf16_t;
typedef short bf16x8 __attribute__((ext_vector_type(8)));
typedef short s16x4 __attribute__((ext_vector_type(4)));
typedef short v4i16_t __attribute__((ext_vector_type(4)));
typedef float f32x4 __attribute__((ext_vector_type(4)));
typedef float f32x16 __attribute__((ext_vector_type(16)));
typedef unsigned u32x4 __attribute__((ext_vector_type(4)));
typedef unsigned u32x2 __attribute__((ext_vector_type(2)));
typedef float f32x2_t __attribute__((ext_vector_type(2)));
typedef __bf16 bf16x2_t __attribute__((ext_vector_type(2)));

constexpr int DM = 1024, SEQ = 2048, NSEQ = 48, NTOK = NSEQ * SEQ, NPROMPT_TOK = 32 * SEQ, NMEM = 256, DIN = 11264;
constexpr int C_AQ = 0, C_AK = 1536, C_AV = 3072, C_AG = 4608, C_BQ = 5120, C_BK = 5632, C_BV = 6144, C_BG = 6656, C_MQ = 7168, C_MG = 7680, C_MERGE = 8192;
constexpr float LOG2E = 1.4426950408889634f;
constexpr float RMS_EPS = 1e-6f;

constexpr size_t OFF_WIN = 0;
constexpr size_t OFF_WKV = OFF_WIN + (size_t)DIN * DM * 2;
constexpr size_t OFF_WP = OFF_WKV + 2097152;
constexpr size_t OFF_WOUT = OFF_WP + 3145728;
constexpr size_t OFF_MEMH = OFF_WOUT + 2097152;
constexpr size_t OFF_MEMKV = OFF_MEMH + (size_t)NSEQ * NMEM * DM * 2;
constexpr size_t OFF_SSQ = OFF_MEMKV + (size_t)NSEQ * NMEM * DM * 2;
constexpr size_t OFF_CTR = OFF_SSQ + (size_t)NTOK * 16 * 4;
constexpr size_t OFF_PCNT = OFF_CTR + 16384;
constexpr size_t OFF_DYN = OFF_PCNT + 384 * 64;
DI constexpr size_t proj_bytes(int ch) { return (size_t)ch * SEQ * DIN * 2; }
DI constexpr size_t merged_bytes(int ch) { return (size_t)ch * SEQ * DM * 2; }
DI constexpr size_t lse_bytes(int ch) { return (size_t)ch * SEQ * 24 * 4; }
DI constexpr size_t hn_bytes(int ch) { return (size_t)ch * SEQ * DM * 2; }
static size_t ws_needed(int ch) { return OFF_DYN + (size_t)ch * SEQ * DM * 2 + (size_t)ch * SEQ * DIN * 2 + (size_t)ch * SEQ * DM * 2 + (size_t)ch * SEQ * 24 * 4; }

#ifndef PROBE
#define PROBE 0
#endif
#ifndef P1_WGM
#define P1_WGM 4
#endif
constexpr int LDS_PHASE = 155648, LDS_BYTES = LDS_PHASE + 64;

struct Args { const float* in[14]; float* out; unsigned char* ws; int ch, nchunk, step_lo, step_hi, coop, pad; };

DI unsigned pk2(float lo, float hi) { f32x2_t v = {lo, hi}; bf16x2_t b = __builtin_convertvector(v, bf16x2_t); return __builtin_bit_cast(unsigned, b); }
DI float bf_lo(unsigned w) { return __uint_as_float(w << 16); }
DI float bf_hi(unsigned w) { return __uint_as_float(w & 0xffff0000u); }
DI float fexp2(float x) { return __builtin_amdgcn_exp2f(x); }
DI float frcp(float x) { return __builtin_amdgcn_rcpf(x); }
DI float sigmoidf_(float x) { return frcp(1.0f + fexp2(-x * LOG2E)); }
DI float siluf_(float x) { return x * sigmoidf_(x); }
DI float wave_sum(float v) {
#pragma unroll
    for (int o = 1; o < 64; o <<= 1) v += __shfl_xor(v, o);
    return v;
}
DI int crow(int r, int hi) { return (r & 3) + 8 * (r >> 2) + 4 * hi; }

namespace pg8 {
constexpr int BM = 256, BK = 64, HALF = 128, HTB = HALF * BK * 2, STAGE_BYTES = 8 * HTB, NXCD = 8, WGM = 8;
DI int lds_byte(int r, int c) { const int st = (r >> 4) * 2 + (c >> 5), rr = r & 15, cc = c & 31, ob = rr * 64 + cc * 2; return st * 1024 + (ob ^ (((ob >> 9) & 1) << 5)); }
DI void stage_rc(int b, int& R, int& C) { const int st = b / 1024, sb = b % 1024, swz = sb ^ (((sb >> 9) & 1) << 5); R = (st >> 1) * 16 + swz / 64; C = (st & 1) * 32 + (swz % 64) / 2; }
DI int perm32(int rho) { const int n = rho >> 4, i = rho & 15; return 8 * (i >> 2) + 4 * n + (i & 3); }

struct Unit { int pm, pn, z; };
struct Gemm { const bf16_t* A; const bf16_t* Bt; int K, lda, ldb, a0, a1, a2; size_t zB; };

struct StaticOrder {
    int nM, nN, nwg, G, c, nz, wgm;
    DI void init(int M, int N, int nz_, int G_, int c_, int wgm_ = WGM) { nM = M / BM; nN = N / BM; nwg = nM * nN; G = G_; c = c_; nz = nz_; wgm = wgm_; }
    DI bool next(int i, Unit& u) const {
        const int it = i / nz; u.z = i - it * nz;
        const long L = (long)it * G + c; if (L >= nwg) return false;
        int wgid = (int)L; { const int q = nwg / NXCD, r = nwg % NXCD, xcd = wgid % NXCD, off = wgid / NXCD; wgid = (xcd < r ? xcd * (q + 1) : r * (q + 1) + (xcd - r) * q) + off; }
        const int nig = wgm * nN, gid = wgid / nig, fm = gid * wgm, gsz = (nM - fm) < wgm ? (nM - fm) : wgm;
        u.pm = fm + ((wgid % nig) % gsz); u.pn = (wgid % nig) / gsz; return true;
    }
};

struct EpiBf16 {
    static constexpr bool PERM = true;
    bf16_t* O; int ldc;
    DI void operator()(f32x4 (&acc)[2][2][4][2], const Unit& u, int wr, int wc, int fr, int fq) const {
        const int row0 = u.pm * BM + wr * 64 + fr; const int col0 = u.pn * BM + wc * 32 + 8 * fq;
#pragma unroll
        for (int ai = 0; ai < 2; ++ai)
#pragma unroll
            for (int m = 0; m < 4; ++m) { bf16_t* rowp = O + (size_t)(row0 + ai * HALF + m * 16) * ldc + col0;
#pragma unroll
                for (int bj = 0; bj < 2; ++bj) { const f32x4 v0 = acc[ai][bj][m][0], v1 = acc[ai][bj][m][1];
                    u32x4 w; w.x = pk2(v0[0], v0[1]); w.y = pk2(v0[2], v0[3]); w.z = pk2(v1[0], v1[1]); w.w = pk2(v1[2], v1[3]);
                    *(u32x4*)(rowp + bj * HALF) = w; } }
    }
};
struct EpiGate {
    static constexpr bool PERM = true;
    const bf16_t* proj; bf16_t* merged;
    DI void operator()(f32x4 (&acc)[2][2][4][2], const Unit& u, int wr, int wc, int fr, int fq) const {
        const int row0 = u.pm * BM + wr * 64 + fr; const int col0 = u.pn * BM + wc * 32 + 8 * fq;
        const bool rmw = (u.z != 0);
#pragma unroll
        for (int ai = 0; ai < 2; ++ai) {
            u32x4 gw[4][2], ov[4][2];
#pragma unroll
            for (int m = 0; m < 4; ++m)
#pragma unroll
                for (int bj = 0; bj < 2; ++bj) { const size_t row = (size_t)(row0 + ai * HALF + m * 16); const int col = col0 + bj * HALF;
                    gw[m][bj] = *(const u32x4*)(proj + row * DIN + C_MERGE + u.z * DM + col);
                    ov[m][bj] = rmw ? *(const u32x4*)(merged + row * DM + col) : (u32x4){0u, 0u, 0u, 0u}; }
            asm volatile("" ::: "memory");
#pragma unroll
            for (int m = 0; m < 4; ++m)
#pragma unroll
                for (int bj = 0; bj < 2; ++bj) { const size_t row = (size_t)(row0 + ai * HALF + m * 16); const int col = col0 + bj * HALF;
                    const f32x4 v0 = acc[ai][bj][m][0], v1 = acc[ai][bj][m][1]; const u32x4 g = gw[m][bj], o = ov[m][bj];
                    const float r0 = sigmoidf_(bf_lo(g.x)) * v0[0] + bf_lo(o.x), r1 = sigmoidf_(bf_hi(g.x)) * v0[1] + bf_hi(o.x), r2 = sigmoidf_(bf_lo(g.y)) * v0[2] + bf_lo(o.y), r3 = sigmoidf_(bf_hi(g.y)) * v0[3] + bf_hi(o.y);
                    const float r4 = sigmoidf_(bf_lo(g.z)) * v1[0] + bf_lo(o.z), r5 = sigmoidf_(bf_hi(g.z)) * v1[1] + bf_hi(o.z), r6 = sigmoidf_(bf_lo(g.w)) * v1[2] + bf_lo(o.w), r7 = sigmoidf_(bf_hi(g.w)) * v1[3] + bf_hi(o.w);
                    u32x4 w; w.x = pk2(r0, r1); w.y = pk2(r2, r3); w.z = pk2(r4, r5); w.w = pk2(r6, r7);
                    *(u32x4*)(merged + row * DM + col) = w; }
        }
    }
};
struct EpiOut {
    static constexpr bool PERM = true;
    const float* xp; const float* xs; float* out; float* xbuf; unsigned* cnt; const float* gain; int tok0; LAS unsigned char* lds_x;
    DI void operator()(f32x4 (&acc)[2][2][4][2], const Unit& u, int wr, int wc, int fr, int fq) const {
        const int row0 = u.pm * BM + wr * 64 + fr; const int col0 = u.pn * BM + wc * 32 + 8 * fq;
        const int tg0 = tok0 + row0;
        const float* xb = (tg0 < NPROMPT_TOK) ? xp + (size_t)tg0 * DM : xs + (size_t)(tg0 - NPROMPT_TOK) * DM;
        LAS float* part = (LAS float*)lds_x;
        LAS float* scl = (LAS float*)(lds_x + 4096);
        volatile LAS unsigned* flag = (volatile LAS unsigned*)(lds_x + 4096 + 1024);
#pragma unroll
        for (int ai = 0; ai < 2; ++ai) {
            f32x4 xv[4][2][2];
#pragma unroll
            for (int m = 0; m < 4; ++m)
#pragma unroll
                for (int bj = 0; bj < 2; ++bj) { const float* xr = xb + (size_t)(ai * HALF + m * 16) * DM + col0 + bj * HALF;
                    xv[m][bj][0] = *(const f32x4*)xr; xv[m][bj][1] = *(const f32x4*)(xr + 4); }
            asm volatile("" ::: "memory");
#pragma unroll
            for (int m = 0; m < 4; ++m) { float sq = 0.f;
#pragma unroll
                for (int bj = 0; bj < 2; ++bj) {
                    const f32x4 y0 = xv[m][bj][0] + acc[ai][bj][m][0], y1 = xv[m][bj][1] + acc[ai][bj][m][1];
                    sq += (y0[0] * y0[0] + y0[1] * y0[1]) + (y0[2] * y0[2] + y0[3] * y0[3]) + (y1[0] * y1[0] + y1[1] * y1[1]) + (y1[2] * y1[2] + y1[3] * y1[3]);
                    acc[ai][bj][m][0] = y0; acc[ai][bj][m][1] = y1; }
                sq += __shfl_xor(sq, 16); sq += __shfl_xor(sq, 32);
                if (fq == 0) part[(ai * HALF + wr * 64 + m * 16 + fr) * 4 + wc] = sq; }
        }
        __syncthreads();
        const int tid = threadIdx.x; const int panel = (tok0 >> 8) + u.pm;
        if (tid < 256) { const float t4 = (part[tid * 4] + part[tid * 4 + 1]) + (part[tid * 4 + 2] + part[tid * 4 + 3]);
            __hip_atomic_store(xbuf + ((size_t)(tok0 + u.pm * BM + tid)) * 4 + u.pn, t4, __ATOMIC_RELAXED, __HIP_MEMORY_SCOPE_AGENT); }
        asm volatile("s_waitcnt vmcnt(0)" ::: "memory");
        __syncthreads();
        if (tid < 64) {
            if (tid == 0) __hip_atomic_fetch_add(cnt + 16 * panel, 1u, __ATOMIC_RELAXED, __HIP_MEMORY_SCOPE_AGENT);
            unsigned sp = 0;
            while ((unsigned)__builtin_amdgcn_readfirstlane(__hip_atomic_load(cnt + 16 * panel, __ATOMIC_RELAXED, __HIP_MEMORY_SCOPE_AGENT)) < 4u) { __builtin_amdgcn_s_sleep(2); if (++sp > (1u << 22)) break; }
            if (tid == 0) flag[0] = 1u;
        }
        __syncthreads();
        if (tid < 256) { const float* xp4 = xbuf + ((size_t)(tok0 + u.pm * BM + tid)) * 4;
            const float a = __hip_atomic_load(xp4, __ATOMIC_RELAXED, __HIP_MEMORY_SCOPE_AGENT), b = __hip_atomic_load(xp4 + 1, __ATOMIC_RELAXED, __HIP_MEMORY_SCOPE_AGENT);
            const float c = __hip_atomic_load(xp4 + 2, __ATOMIC_RELAXED, __HIP_MEMORY_SCOPE_AGENT), d = __hip_atomic_load(xp4 + 3, __ATOMIC_RELAXED, __HIP_MEMORY_SCOPE_AGENT);
            scl[tid] = __builtin_amdgcn_rsqf(((a + b) + (c + d)) * (1.0f / DM) + RMS_EPS); }
        __syncthreads();
        f32x4 gv[2][2];
#pragma unroll
        for (int bj = 0; bj < 2; ++bj) { gv[bj][0] = *(const f32x4*)(gain + col0 + bj * HALF); gv[bj][1] = *(const f32x4*)(gain + col0 + bj * HALF + 4); }
#pragma unroll
        for (int ai = 0; ai < 2; ++ai)
#pragma unroll
            for (int m = 0; m < 4; ++m) { const int rl = ai * HALF + wr * 64 + m * 16 + fr; const float sc = scl[rl];
                float* orow = out + (size_t)(tok0 + u.pm * BM + rl) * DM;
#pragma unroll
                for (int bj = 0; bj < 2; ++bj) { const int col = col0 + bj * HALF;
                    *(f32x4*)(orow + col) = acc[ai][bj][m][0] * sc * gv[bj][0]; *(f32x4*)(orow + col + 4) = acc[ai][bj][m][1] * sc * gv[bj][1]; } }
        __syncthreads();
    }
};

template <class Epi, class Sched>
DI void gemm_phase(LAS unsigned char* lds, const Gemm g, const Sched& S, const Epi& E, const int tid) {
    const int wid = __builtin_amdgcn_readfirstlane(tid >> 6), lane = tid & 63, wr = wid >> 2, wc = wid & 3, fr = lane & 15, fq = lane >> 4;
    const int K = g.K, nt = K / BK;
    unsigned voffA[2], voffB[2];
#pragma unroll
    for (int i = 0; i < 2; ++i) { int R, C; stage_rc(tid * 16 + i * 8192, R, C); const int Rb = Epi::PERM ? ((R & ~31) + perm32(R & 31)) : R;
        voffA[i] = (unsigned)(R * g.lda + C) * 2u; voffB[i] = (unsigned)(Rb * g.ldb + C) * 2u; }
    const size_t kstep = (size_t)(BK * 2);
    const size_t hstepA = (size_t)HALF * g.lda * 2, hstepB = (size_t)HALF * g.ldb * 2;
    const size_t tstepA = 2 * hstepA, tstepB = 2 * hstepB;
    const unsigned ldsw = (unsigned)wid * 1024u;
    const int aoff = lds_byte(wr * 64 + fr, fq * 8), boff = lds_byte(wc * 32 + fr, fq * 8);
#define PG8_SA(b, h) (((b) * 2 + (h)) * HTB)
#define PG8_SB(b, h) ((4 + (b) * 2 + (h)) * HTB)
#define PG8_STAGE(bufoff, gbase, voff) do { _Pragma("unroll") for (int _i = 0; _i < 2; ++_i) \
        __builtin_amdgcn_global_load_lds((const unsigned*)((const char*)(gbase) + (voff)[_i]), (LAS unsigned*)(lds + (bufoff) + ldsw + _i * 8192), 16, 0, 0); } while (0)
#define PG8_LDA(dst, b, h) do { _Pragma("unroll") for (int m = 0; m < 4; ++m) _Pragma("unroll") for (int k = 0; k < 2; ++k) dst[m][k] = *(const LAS bf16x8*)(lds + PG8_SA(b, h) + aoff + m * 2048 + k * 1024); } while (0)
#define PG8_LDB(dst, b, h) do { _Pragma("unroll") for (int n = 0; n < 2; ++n) _Pragma("unroll") for (int k = 0; k < 2; ++k) dst[n][k] = *(const LAS bf16x8*)(lds + PG8_SB(b, h) + boff + n * 2048 + k * 1024); } while (0)
#define PG8_MMA(ai, bj, At, Bt) do { __builtin_amdgcn_s_setprio(1); _Pragma("unroll") for (int m = 0; m < 4; ++m) _Pragma("unroll") for (int n = 0; n < 2; ++n) _Pragma("unroll") for (int k = 0; k < 2; ++k) \
        acc[ai][bj][m][n] = __builtin_amdgcn_mfma_f32_16x16x32_bf16(Bt[n][k], At[m][k], acc[ai][bj][m][n], 0, 0, 0); __builtin_amdgcn_s_setprio(0); } while (0)
#define PG8_WAIT_V(n) asm volatile("s_waitcnt vmcnt(" #n ")" ::: "memory")
#define PG8_WAIT_L(n) asm volatile("s_waitcnt lgkmcnt(" #n ")" ::: "memory")
#define PG8_BAR __builtin_amdgcn_s_barrier()
#define PG8_SCHED __builtin_amdgcn_sched_barrier(0)
#define PG8_APTR(u) ((const char*)g.A + (size_t)((u).z == 0 ? g.a0 : ((u).z == 1 ? g.a1 : g.a2)) * 2 + (size_t)(u).pm * tstepA)
#define PG8_BPTR(u) ((const char*)g.Bt + (size_t)(u).z * g.zB * 2 + (size_t)(u).pn * tstepB)
    Unit cur, nxt; int ui = 0;
    if (!S.next(0, cur)) return;
    f32x4 acc[2][2][4][2];
#pragma unroll
    for (int a = 0; a < 2; ++a)
#pragma unroll
        for (int b = 0; b < 2; ++b)
#pragma unroll
            for (int m = 0; m < 4; ++m)
#pragma unroll
                for (int n = 0; n < 2; ++n) acc[a][b][m][n] = (f32x4){0.f, 0.f, 0.f, 0.f};
    bf16x8 At[4][2], B0[2][2], B1[2][2];
    const char* cA = PG8_APTR(cur); const char* cB = PG8_BPTR(cur);
    PG8_STAGE(PG8_SB(0, 0), cB, voffB); PG8_STAGE(PG8_SB(0, 1), cB + hstepB, voffB); PG8_STAGE(PG8_SA(0, 0), cA, voffA); PG8_STAGE(PG8_SA(0, 1), cA + hstepA, voffA);
    if (wr == 1) PG8_BAR;
    PG8_WAIT_V(2); PG8_BAR;
    PG8_STAGE(PG8_SB(1, 0), cB + kstep, voffB); PG8_STAGE(PG8_SA(1, 0), cA + kstep, voffA); PG8_STAGE(PG8_SB(1, 1), cB + hstepB + kstep, voffB);
    PG8_WAIT_V(6); PG8_BAR;
    for (;;) {
        const bool has_next = S.next(ui + 1, nxt);
        const char* nA = has_next ? PG8_APTR(nxt) : cA; const char* nB = has_next ? PG8_BPTR(nxt) : cB;
        for (int t = 0; t < nt; t += 2) {
            const bool last = (t == nt - 2);
            const char* a1 = cA + (size_t)(t + 1) * kstep;
            const char* a2 = last ? nA : cA + (size_t)(t + 2) * kstep; const char* b2 = last ? nB : cB + (size_t)(t + 2) * kstep;
            const char* a3 = a2 + kstep; const char* b3 = b2 + kstep;
            PG8_LDB(B0, 0, 0); PG8_LDB(B1, 0, 1); PG8_SCHED; PG8_LDA(At, 0, 0); PG8_STAGE(PG8_SA(1, 1), a1 + hstepA, voffA);
            PG8_WAIT_V(8); PG8_WAIT_L(0); PG8_BAR; PG8_MMA(0, 0, At, B0); PG8_MMA(0, 1, At, B1); PG8_BAR; PG8_SCHED;
            PG8_LDA(At, 0, 1); PG8_STAGE(PG8_SB(0, 0), b2, voffB); PG8_STAGE(PG8_SB(0, 1), b2 + hstepB, voffB); PG8_STAGE(PG8_SA(0, 0), a2, voffA);
            PG8_WAIT_V(8); PG8_WAIT_L(0); PG8_BAR; PG8_MMA(1, 0, At, B0); PG8_MMA(1, 1, At, B1); PG8_BAR; PG8_SCHED;
            PG8_LDB(B0, 1, 0); PG8_LDB(B1, 1, 1); PG8_SCHED; PG8_LDA(At, 1, 0); PG8_STAGE(PG8_SA(0, 1), a2 + hstepA, voffA);
            PG8_WAIT_V(8); PG8_WAIT_L(0); PG8_BAR; PG8_MMA(0, 0, At, B0); PG8_MMA(0, 1, At, B1); PG8_BAR; PG8_SCHED;
            PG8_LDA(At, 1, 1); PG8_STAGE(PG8_SB(1, 0), b3, voffB); PG8_STAGE(PG8_SB(1, 1), b3 + hstepB, voffB); PG8_STAGE(PG8_SA(1, 0), a3, voffA);
            PG8_WAIT_V(8); PG8_WAIT_L(0); PG8_BAR; PG8_MMA(1, 0, At, B0); PG8_MMA(1, 1, At, B1); PG8_BAR; PG8_SCHED;
        }
        if (wr == 0) PG8_BAR;
        E(acc, cur, wr, wc, fr, fq);
        if (!has_next) break;
#pragma unroll
        for (int a = 0; a < 2; ++a)
#pragma unroll
            for (int b = 0; b < 2; ++b)
#pragma unroll
                for (int m = 0; m < 4; ++m)
#pragma unroll
                    for (int n = 0; n < 2; ++n) acc[a][b][m][n] = (f32x4){0.f, 0.f, 0.f, 0.f};
        cur = nxt; cA = nA; cB = nB; ++ui;
        if (wr == 1) PG8_BAR;
    }
    PG8_WAIT_V(0);
    PG8_BAR;
#undef PG8_SA
#undef PG8_SB
#undef PG8_STAGE
#undef PG8_LDA
#undef PG8_LDB
#undef PG8_MMA
#undef PG8_WAIT_V
#undef PG8_WAIT_L
#undef PG8_BAR
#undef PG8_SCHED
#undef PG8_APTR
#undef PG8_BPTR
}
}

#define MFMA32(a, b, c) __builtin_amdgcn_mfma_f32_32x32x16_bf16((a), (b), (c), 0, 0, 0)
DI s16x4 vtr(LAS unsigned char* p) { return __builtin_bit_cast(s16x4, __builtin_amdgcn_ds_read_tr16_b64_v4i16((LAS v4i16_t*)p)); }

template <int D, class MaskT>
DI void tile_compute(const LAS unsigned char* krd, LAS unsigned char* vrd, const bf16x8 (&qf)[D / 16], const MaskT& maskt, f32x16 (&o)[D / 32], float& m, float& l) {
    constexpr int NKS = D / 16, NDB = D / 32;
    typedef float f32x8_t __attribute__((ext_vector_type(8)));
    f32x16 s;
#pragma unroll
    for (int i = 0; i < 16; ++i) s[i] = 0.f;
#pragma unroll
    for (int ks = 0; ks < NKS; ++ks) { const bf16x8 kf = *(const LAS bf16x8*)(krd + ks * 32); s = MFMA32(kf, qf[ks], s); }
    maskt(s);
    float mx = fmaxf(fmaxf(s[0], s[1]), s[2]);
    mx = fmaxf(fmaxf(mx, s[3]), s[4]); mx = fmaxf(fmaxf(mx, s[5]), s[6]); mx = fmaxf(fmaxf(mx, s[7]), s[8]); mx = fmaxf(fmaxf(mx, s[9]), s[10]);
    mx = fmaxf(fmaxf(mx, s[11]), s[12]); mx = fmaxf(fmaxf(mx, s[13]), s[14]); mx = fmaxf(mx, s[15]);
    mx = fmaxf(mx, __shfl_xor(mx, 32));
    const float mn = fmaxf(m, mx);
    if (__builtin_amdgcn_ballot_w64(mn > m) != 0ull) {
        const float alpha = fexp2(m - mn); l *= alpha;
#pragma unroll
        for (int d = 0; d < NDB; ++d) o[d] = o[d] * alpha;
    }
    m = mn;
    s = s - mn;
#pragma unroll
    for (int i = 0; i < 16; ++i) s[i] = fexp2(s[i]);
    { const f32x8_t a8 = s.lo + s.hi; const f32x4 a4 = a8.lo + a8.hi; l += (a4[0] + a4[1]) + (a4[2] + a4[3]); }
    u32x4 p0, p1;
    p0.x = pk2(s[0], s[1]); p0.y = pk2(s[2], s[3]); p0.z = pk2(s[4], s[5]); p0.w = pk2(s[6], s[7]);
    p1.x = pk2(s[8], s[9]); p1.y = pk2(s[10], s[11]); p1.z = pk2(s[12], s[13]); p1.w = pk2(s[14], s[15]);
    const bf16x8 pb0 = __builtin_bit_cast(bf16x8, p0), pb1 = __builtin_bit_cast(bf16x8, p1);
#pragma unroll
    for (int d = 0; d < NDB; ++d) {
        const s16x4 a0 = vtr(vrd + d * 2048), a1 = vtr(vrd + d * 2048 + 8 * 64);
        const s16x4 b0 = vtr(vrd + d * 2048 + 16 * 64), b1 = vtr(vrd + d * 2048 + 24 * 64);
        const bf16x8 va0 = __builtin_shufflevector(a0, a1, 0, 1, 2, 3, 4, 5, 6, 7), va1 = __builtin_shufflevector(b0, b1, 0, 1, 2, 3, 4, 5, 6, 7);
        o[d] = MFMA32(va0, pb0, o[d]);
        o[d] = MFMA32(va1, pb1, o[d]);
    }
}

template <int D, class MaskA, class MaskB>
DI void tile_compute2(const LAS unsigned char* krdA, LAS unsigned char* vrdA, const LAS unsigned char* krdB, LAS unsigned char* vrdB, const bf16x8 (&qf)[D / 16],
                      const MaskA& maskA, const MaskB& maskB, f32x16 (&o)[D / 32], float& m, float& l) {
    constexpr int NKS = D / 16, NDB = D / 32;
    typedef float f32x8_t __attribute__((ext_vector_type(8)));
    f32x16 sa, sb;
#pragma unroll
    for (int i = 0; i < 16; ++i) { sa[i] = 0.f; sb[i] = 0.f; }
#pragma unroll
    for (int ks = 0; ks < NKS; ++ks) { const bf16x8 ka = *(const LAS bf16x8*)(krdA + ks * 32), kb = *(const LAS bf16x8*)(krdB + ks * 32);
        sa = MFMA32(ka, qf[ks], sa); sb = MFMA32(kb, qf[ks], sb); }
    maskA(sa); maskB(sb);
    float mx = fmaxf(fmaxf(sa[0], sa[1]), sa[2]);
#pragma unroll
    for (int i = 3; i < 15; i += 2) mx = fmaxf(fmaxf(mx, sa[i]), sa[i + 1]);
    mx = fmaxf(fmaxf(mx, sa[15]), sb[0]);
#pragma unroll
    for (int i = 1; i < 15; i += 2) mx = fmaxf(fmaxf(mx, sb[i]), sb[i + 1]);
    mx = fmaxf(mx, sb[15]);
    mx = fmaxf(mx, __shfl_xor(mx, 32));
    const float mn = fmaxf(m, mx);
    if (__builtin_amdgcn_ballot_w64(mn > m) != 0ull) {
        const float alpha = fexp2(m - mn); l *= alpha;
#pragma unroll
        for (int d = 0; d < NDB; ++d) o[d] = o[d] * alpha;
    }
    m = mn;
    sa = sa - mn; sb = sb - mn;
#pragma unroll
    for (int i = 0; i < 16; ++i) { sa[i] = fexp2(sa[i]); sb[i] = fexp2(sb[i]); }
    { const f32x16 t = sa + sb; const f32x8_t a8 = t.lo + t.hi; const f32x4 a4 = a8.lo + a8.hi; l += (a4[0] + a4[1]) + (a4[2] + a4[3]); }
    u32x4 p0, p1, p2, p3;
    p0.x = pk2(sa[0], sa[1]); p0.y = pk2(sa[2], sa[3]); p0.z = pk2(sa[4], sa[5]); p0.w = pk2(sa[6], sa[7]);
    p1.x = pk2(sa[8], sa[9]); p1.y = pk2(sa[10], sa[11]); p1.z = pk2(sa[12], sa[13]); p1.w = pk2(sa[14], sa[15]);
    p2.x = pk2(sb[0], sb[1]); p2.y = pk2(sb[2], sb[3]); p2.z = pk2(sb[4], sb[5]); p2.w = pk2(sb[6], sb[7]);
    p3.x = pk2(sb[8], sb[9]); p3.y = pk2(sb[10], sb[11]); p3.z = pk2(sb[12], sb[13]); p3.w = pk2(sb[14], sb[15]);
    const bf16x8 pa0 = __builtin_bit_cast(bf16x8, p0), pa1 = __builtin_bit_cast(bf16x8, p1), pb0 = __builtin_bit_cast(bf16x8, p2), pb1 = __builtin_bit_cast(bf16x8, p3);
#pragma unroll
    for (int d = 0; d < NDB; ++d) {
        const s16x4 a0 = vtr(vrdA + d * 2048), a1 = vtr(vrdA + d * 2048 + 8 * 64), a2 = vtr(vrdA + d * 2048 + 16 * 64), a3 = vtr(vrdA + d * 2048 + 24 * 64);
        const s16x4 b0 = vtr(vrdB + d * 2048), b1 = vtr(vrdB + d * 2048 + 8 * 64), b2 = vtr(vrdB + d * 2048 + 16 * 64), b3 = vtr(vrdB + d * 2048 + 24 * 64);
        o[d] = MFMA32(__builtin_shufflevector(a0, a1, 0, 1, 2, 3, 4, 5, 6, 7), pa0, o[d]);
        o[d] = MFMA32(__builtin_shufflevector(a2, a3, 0, 1, 2, 3, 4, 5, 6, 7), pa1, o[d]);
        o[d] = MFMA32(__builtin_shufflevector(b0, b1, 0, 1, 2, 3, 4, 5, 6, 7), pb0, o[d]);
        o[d] = MFMA32(__builtin_shufflevector(b2, b3, 0, 1, 2, 3, 4, 5, 6, 7), pb1, o[d]);
    }
}

template <int D, class KTok, class MaskF>
DI void attn_run(const bf16_t* qp, const bf16_t* kbase, const bf16_t* vbase, size_t pitch, int ntiles, const KTok& ktok, const MaskF& maskf,
                 LAS unsigned char* vimg, f32x16 (&o)[D / 32], float& m_out, float& l_out, const int lane) {
    const int r = lane & 31, hi = lane >> 5;
    constexpr int NKS = D / 16, NDB = D / 32, CPR = D / 8, RPI = 64 / CPR, NI = 32 / RPI, KSTR = D * 2 + 16;
    LAS unsigned char* kimg = vimg + D * 64;
    bf16x8 qf[NKS];
#pragma unroll
    for (int ks = 0; ks < NKS; ++ks) qf[ks] = *(const bf16x8*)(qp + 16 * ks + 8 * hi);
#pragma unroll
    for (int d = 0; d < NDB; ++d)
#pragma unroll
        for (int i = 0; i < 16; ++i) o[d][i] = 0.f;
    float m = -1e30f, l = 0.f;
    const int vkey = lane / CPR, vc = lane % CPR;
    LAS unsigned char* vwr = vimg + (vc >> 2) * 2048 + vkey * 64 + (vc & 3) * 16;
    LAS unsigned char* kwr = kimg + vkey * KSTR + vc * 16;
    const LAS unsigned char* krd = kimg + r * KSTR + hi * 16;
    const int dgrp = (lane >> 4) & 1, tq = (lane & 15) >> 2, tp = lane & 3;
    LAS unsigned char* vrd = vimg + (4 * hi + tq) * 64 + (16 * dgrp + 4 * tp) * 2;
    u32x4 kk[3][NI], vv[3][NI];
#define AR_LOAD(J, T) do { const int _t = ((T) < ntiles) ? (T) : (ntiles - 1); _Pragma("unroll") for (int i = 0; i < NI; ++i) { \
        const size_t ro = (size_t)ktok(_t, i * RPI + vkey) * pitch + 8 * vc; kk[J][i] = *(const u32x4*)(kbase + ro); vv[J][i] = *(const u32x4*)(vbase + ro); } } while (0)
#define AR_STEP(J, T) do { _Pragma("unroll") for (int i = 0; i < NI; ++i) { *(LAS u32x4*)(kwr + i * RPI * KSTR) = kk[J][i]; *(LAS u32x4*)(vwr + i * RPI * 64) = vv[J][i]; } \
        asm volatile("" ::: "memory"); AR_LOAD(J, (T) + 3); \
        { const int _tt = (T); tile_compute<D>(krd, vrd, qf, [&](f32x16& s) { maskf(_tt, s); }, o, m, l); } asm volatile("" ::: "memory"); } while (0)
    AR_LOAD(0, 0); AR_LOAD(1, 1); AR_LOAD(2, 2);
    for (int t = 0; t < ntiles; t += 3) {
        AR_STEP(0, t);
        if (t + 1 < ntiles) AR_STEP(1, t + 1);
        if (t + 2 < ntiles) AR_STEP(2, t + 2);
    }
#undef AR_LOAD
#undef AR_STEP
    m_out = m; l_out = l + __shfl_xor(l, 32);
}

struct Ctx {
    const float* in[14]; float* out; unsigned char* ws;
    bf16_t *win_t, *wkv_t, *wp_t, *wout_t, *hn, *memh, *memkv, *proj, *merged; float *ssq, *lse;
    int ch, G, tid, bid;
};

DI void unit_M(const Ctx& X, int chunk, int u, LAS unsigned char* vimg, int dry) {
    const int lane = X.tid & 63, r = lane & 31, hi = lane >> 5;
    const int seq = u >> 8, rem = u & 255, h = rem >> 6, tile = rem & 63;
    const int tok = seq * SEQ + tile * 32 + r;
    bf16_t* prow = X.proj + (size_t)tok * DIN;
    const int gseq = chunk * X.ch + seq;
    const bf16_t* kb = X.memkv + (size_t)gseq * NMEM * DM + h * 128;
    f32x16 o[4]; float m, l;
    const float c1 = 0.08838834764831845f * LOG2E;
    attn_run<128>(prow + C_MQ + h * 128, kb, kb + 512, (size_t)DM, 8,
                  [](int t, int kk) { return t * 32 + kk; },
                  [c1](int, f32x16& s) {
#pragma unroll
                      for (int i = 0; i < 16; ++i) s[i] *= c1; },
                  vimg, o, m, l, lane);
    const float inv = frcp(l);
#pragma unroll
    for (int d = 0; d < 4; ++d)
#pragma unroll
        for (int gq = 0; gq < 4; ++gq) {
            const int d0 = 32 * d + 8 * gq + 4 * hi;
            const u32x2 gt = *(const u32x2*)(prow + C_MG + h * 128 + d0);
            u32x2 w; w.x = pk2(o[d][4 * gq] * inv * siluf_(bf_lo(gt.x)), o[d][4 * gq + 1] * inv * siluf_(bf_hi(gt.x)));
            w.y = pk2(o[d][4 * gq + 2] * inv * siluf_(bf_lo(gt.y)), o[d][4 * gq + 3] * inv * siluf_(bf_hi(gt.y)));
            *(u32x2*)(dry ? X.merged + (size_t)tok * DM + h * 128 + d0 : prow + C_MQ + h * 128 + d0) = w;
        }
}

DI void unit_B(const Ctx& X, int u, LAS unsigned char* vimg, const LAS float* rpb_lds, int dry) {
    const int lane = X.tid & 63, r = lane & 31, hi = lane >> 5;
    const int seq = u >> 9, rem = u & 511, h = rem >> 6, pt = rem & 63, rp = pt >> 2, cb = pt & 3;
    const int qr = 2 * rp + (r >> 4), qc = 16 * cb + (r & 15);
    const int tok = seq * SEQ + qr * 64 + qc;
    bf16_t* prow = X.proj + (size_t)tok * DIN;
    const int ra = 2 * rp - 4, rb = 2 * rp + 1 - 4;
    const int krlo = ra < 0 ? 0 : (ra > 24 ? 24 : ra), krhi = (rb < 0 ? 0 : (rb > 24 ? 24 : rb)) + 7;
    const int sc0 = 16 * cb - 8; const int kstart0 = sc0 < 0 ? 0 : (sc0 > 48 ? 48 : sc0); const int kstart = kstart0 > 32 ? 32 : kstart0;
    const int r0q = (qr - 4) < 0 ? 0 : ((qr - 4) > 24 ? 24 : (qr - 4));
    const int scq = (qc - 8) < 0 ? 0 : ((qc - 8) > 48 ? 48 : (qc - 8));
    const int lo = scq - kstart;
    const float fl = (float)(4 * hi - lo) - 7.5f;
    const int dcb = kstart - qc + 15 + 16 + 4 * hi;
    const LAS float* rp_h = rpb_lds + h * (15 * 64);
    const bf16_t* kb = X.proj + (size_t)seq * SEQ * DIN + C_BK + h * 64;
    const float c1 = 0.125f * LOG2E;
    f32x16 o[2]; float m, l;
#if PROBE == 8
    const size_t bpitch = dry ? (size_t)64 : (size_t)DIN;
#else
    const size_t bpitch = DIN;
#endif
#if PROBE == 9
    const int bnt = dry ? 1 : (krhi - krlo + 1);
#else
    const int bnt = krhi - krlo + 1;
#endif
    attn_run<64>(prow + C_BQ + h * 64, kb, kb + (C_BV - C_BK), bpitch, bnt,
                 [krlo, kstart](int t, int kk) { return (krlo + t) * 64 + kstart + kk; },
                 [=](int t, f32x16& s) {
                     const int kr = krlo + t; const bool rowok = (kr >= r0q) && (kr <= r0q + 7);
                     int dr = kr - qr + 7; dr = dr < 0 ? 0 : (dr > 14 ? 14 : dr);
                     const volatile LAS float* bp = rp_h + dr * 64 + dcb;
                     const float flt = rowok ? fl : 1e9f;
#define BEL(i, CF) { const float b = bp[CF]; const float tt = (float)(CF) + flt; s[i] = (fabsf(tt) <= 7.5f) ? fmaf(s[i], c1, b) : -1e30f; }
                     BEL(0, 0) BEL(1, 1) BEL(2, 2) BEL(3, 3) BEL(4, 8) BEL(5, 9) BEL(6, 10) BEL(7, 11) BEL(8, 16) BEL(9, 17) BEL(10, 18) BEL(11, 19) BEL(12, 24) BEL(13, 25) BEL(14, 26) BEL(15, 27)
#undef BEL
                 },
                 vimg, o, m, l, lane);
    const float inv = frcp(l);
#pragma unroll
    for (int d = 0; d < 2; ++d)
#pragma unroll
        for (int gq = 0; gq < 4; ++gq) {
            const int d0 = 32 * d + 8 * gq + 4 * hi;
            const u32x2 gt = *(const u32x2*)(prow + C_BG + h * 64 + d0);
            u32x2 w; w.x = pk2(o[d][4 * gq] * inv * siluf_(bf_lo(gt.x)), o[d][4 * gq + 1] * inv * siluf_(bf_hi(gt.x)));
            w.y = pk2(o[d][4 * gq + 2] * inv * siluf_(bf_lo(gt.y)), o[d][4 * gq + 3] * inv * siluf_(bf_hi(gt.y)));
            *(u32x2*)(dry ? X.merged + (size_t)tok * DM + 512 + h * 64 + d0 : prow + C_BQ + h * 64 + d0) = w;
        }
}

DI void unit_A(const Ctx& X, int u, LAS unsigned char* vimg, int dry) {
    const int lane = X.tid & 63, r = lane & 31, hi = lane >> 5;
    const int seq = u / 1536, rem = u - seq * 1536, g = rem >> 9, rem2 = rem & 511, h = rem2 >> 6, tt = rem2 & 63;
    const int sh = 2 * g, tpr = 64 >> sh, res = tt / tpr, tl = tt - res * tpr;
    const int tok = seq * SEQ + (((32 * tl + r) << sh) + res);
    bf16_t* prow = X.proj + (size_t)tok * DIN;
    const int jt0 = (tl - 2) < 0 ? 0 : (tl - 2), jt1 = (tl + 2) > (tpr - 1) ? (tpr - 1) : (tl + 2);
    const float slope = fexp2(-(float)(g * 8 + h + 1) * (1.0f / 3.0f));
    const float c1 = 0.125f * LOG2E, c2 = slope * (float)(1 << sh) * LOG2E;
    const bf16_t* kb = X.proj + ((size_t)seq * SEQ + res) * DIN + C_AK + g * 512 + h * 64;
    f32x16 o[2]; float m, l;
    attn_run<64>(prow + C_AQ + g * 512 + h * 64, kb, kb + (C_AV - C_AK), (size_t)DIN, jt1 - jt0 + 1,
                 [jt0, sh](int t, int kk) { return (32 * (jt0 + t) + kk) << sh; },
                 [=](int t, f32x16& s) {
                     const int base = 32 * (jt0 + t - tl) - r;
#pragma unroll
                     for (int i = 0; i < 16; ++i) { const int off = base + crow(i, hi); const int ao = off < 0 ? -off : off;
                         s[i] = (ao <= 64) ? (s[i] * c1 - c2 * (float)ao) : -1e30f; } },
                 vimg, o, m, l, lane);
    const float inv = frcp(l);
#pragma unroll
    for (int d = 0; d < 2; ++d)
#pragma unroll
        for (int gq = 0; gq < 4; ++gq) {
            const int d0 = 32 * d + 8 * gq + 4 * hi;
            u32x2 w; w.x = pk2(o[d][4 * gq] * inv, o[d][4 * gq + 1] * inv); w.y = pk2(o[d][4 * gq + 2] * inv, o[d][4 * gq + 3] * inv);
            *(u32x2*)(dry ? X.merged + (size_t)tok * DM + ((g * 512 + h * 64 + d0) & 1023) : prow + C_AQ + g * 512 + h * 64 + d0) = w;
        }
    if (hi == 0) X.lse[(size_t)tok * 24 + g * 8 + h] = m + __builtin_amdgcn_logf(l);
}

DI void rms_rows(const float* __restrict__ src, const float* __restrict__ gain, bf16_t* dst, int nrows, int gw, int nw, int tid) {
    const int lane = tid & 63;
    f32x4 gv[4];
#pragma unroll
    for (int i = 0; i < 4; ++i) gv[i] = *(const f32x4*)(gain + i * 256 + lane * 4);
    for (int row = gw; row < nrows; row += nw) {
        const float* p = src + (size_t)row * DM; f32x4 v[4]; float ss = 0.f;
#pragma unroll
        for (int i = 0; i < 4; ++i) { v[i] = *(const f32x4*)(p + i * 256 + lane * 4); ss += (v[i][0] * v[i][0] + v[i][1] * v[i][1]) + (v[i][2] * v[i][2] + v[i][3] * v[i][3]); }
        ss = wave_sum(ss);
        const float sc = __builtin_amdgcn_rsqf(ss * (1.0f / DM) + RMS_EPS);
#pragma unroll
        for (int i = 0; i < 4; ++i) { u32x2 w; w.x = pk2(v[i][0] * sc * gv[i][0], v[i][1] * sc * gv[i][1]); w.y = pk2(v[i][2] * sc * gv[i][2], v[i][3] * sc * gv[i][3]);
            *(u32x2*)(dst + (size_t)row * DM + i * 256 + lane * 4) = w; }
    }
}

DI void rms_tokens(const float* __restrict__ xp, const float* __restrict__ xs, const float* __restrict__ gain, bf16_t* dst, int tok0, int nrows, int gw, int nw, int tid, int split = NPROMPT_TOK) {
    const int lane = tid & 63;
    f32x4 gv[4];
#pragma unroll
    for (int i = 0; i < 4; ++i) gv[i] = *(const f32x4*)(gain + i * 256 + lane * 4);
    for (int row0 = gw; row0 < nrows; row0 += 4 * nw) {
        f32x4 v[4][4];
#pragma unroll
        for (int u = 0; u < 4; ++u) { const int row = (row0 + u * nw < nrows) ? row0 + u * nw : row0; const int tg = tok0 + row;
            const float* p = (tg < split) ? xp + (size_t)tg * DM : xs + (size_t)(tg - split) * DM;
#pragma unroll
            for (int i = 0; i < 4; ++i) v[u][i] = *(const f32x4*)(p + i * 256 + lane * 4); }
#pragma unroll
        for (int u = 0; u < 4; ++u) { const int row = row0 + u * nw; float ss = 0.f;
#pragma unroll
            for (int i = 0; i < 4; ++i) ss += (v[u][i][0] * v[u][i][0] + v[u][i][1] * v[u][i][1]) + (v[u][i][2] * v[u][i][2] + v[u][i][3] * v[u][i][3]);
            ss = wave_sum(ss);
            const float sc = __builtin_amdgcn_rsqf(ss * (1.0f / DM) + RMS_EPS);
            if (row < nrows) {
#pragma unroll
                for (int i = 0; i < 4; ++i) { u32x2 w; w.x = pk2(v[u][i][0] * sc * gv[i][0], v[u][i][1] * sc * gv[i][1]); w.y = pk2(v[u][i][2] * sc * gv[i][2], v[u][i][3] * sc * gv[i][3]);
                    *(u32x2*)(dst + (size_t)row * DM + i * 256 + lane * 4) = w; } } }
    }
}

DI void transpose_tiles(const float* __restrict__ W, int K, int N, bf16_t* WT, LAS float* tile, int bid, int nb, int tid) {
    const int tn = N / 64, ntile = (K / 64) * tn;
    for (int t = bid; t < ntile; t += nb) {
        const int k0 = (t / tn) * 64, n0 = (t % tn) * 64;
#pragma unroll
        for (int i = 0; i < 2; ++i) { const int kk = (tid >> 4) + 32 * i, n4 = (tid & 15) * 4;
            const f32x4 v = *(const f32x4*)(W + (size_t)(k0 + kk) * N + n0 + n4);
            tile[kk * 65 + n4] = v[0]; tile[kk * 65 + n4 + 1] = v[1]; tile[kk * 65 + n4 + 2] = v[2]; tile[kk * 65 + n4 + 3] = v[3]; }
        __syncthreads();
        { const int n = tid >> 3, kc = (tid & 7) * 8;
          u32x4 w; w.x = pk2(tile[(kc + 0) * 65 + n], tile[(kc + 1) * 65 + n]); w.y = pk2(tile[(kc + 2) * 65 + n], tile[(kc + 3) * 65 + n]);
          w.z = pk2(tile[(kc + 4) * 65 + n], tile[(kc + 5) * 65 + n]); w.w = pk2(tile[(kc + 6) * 65 + n], tile[(kc + 7) * 65 + n]);
          *(u32x4*)(WT + (size_t)(n0 + n) * K + k0 + kc) = w; }
        __syncthreads();
    }
}

DI void phase_p0(const Ctx& X, LAS unsigned char* lds) {
    const int tid = X.tid; const int wave = __builtin_amdgcn_readfirstlane(tid >> 6);
    const int gw = X.bid * 8 + wave, nw = X.G * 8, bid = X.bid, nb = X.G;
    LAS float* tile = (LAS float*)lds;
    transpose_tiles(X.in[6], DM, DIN, X.win_t, tile, bid, nb, tid);
    transpose_tiles(X.in[7], DM, DM, X.wkv_t, tile, (bid + 64) % nb, nb, tid);
    transpose_tiles(X.in[9], 512, DM, X.wp_t, tile, (bid + 128) % nb, nb, tid);
    transpose_tiles(X.in[10], 512, DM, X.wp_t + 1024 * 512, tile, (bid + 160) % nb, nb, tid);
    transpose_tiles(X.in[11], 512, DM, X.wp_t + 2 * 1024 * 512, tile, (bid + 192) % nb, nb, tid);
    transpose_tiles(X.in[12], DM, DM, X.wout_t, tile, (bid + 224) % nb, nb, tid);
    rms_tokens(X.in[0], X.in[1], X.in[4], X.hn, 0, X.ch * SEQ, gw, nw, tid);
    rms_tokens(X.in[2], X.in[3], X.in[5], X.memh, 0, NSEQ * NMEM, gw, nw, tid, 32 * NMEM);
}

constexpr int A_SLOT = 8704;
struct AUnit { int seq, g, h, blk; };
DI AUnit a_decode(int ub) { AUnit a; a.seq = ub / 192; const int rem = ub - a.seq * 192; a.g = rem >> 6; a.h = (rem & 63) >> 3; a.blk = rem & 7; return a; }
DI void a_issue(const Ctx& X, const AUnit& a, int wave, int lkv, int lkey, int lc, int r, int hi, u32x4 (&L)[12], bf16x8 (&qn)[4]) {
    const int sh = 2 * a.g, T = 64 >> sh;
    const bf16_t* base = X.proj + (size_t)a.seq * SEQ * DIN + (lkv ? C_AV : C_AK) + a.g * 512 + a.h * 64 + 8 * lc;
    const int res01 = (a.g == 0) ? 0 : (a.blk >> 1), qt0 = (a.g == 0) ? 8 * a.blk : 8 * (a.blk & 1);
#pragma unroll
    for (int j = 0; j < 12; ++j) {
        int res_j, kt_j; bool valid;
        if (a.g < 2) { res_j = res01; kt_j = qt0 - 2 + j; valid = (kt_j >= 0) && (kt_j < T); }
        else { res_j = 2 * a.blk + (j >> 2); kt_j = j & 3; valid = (j < 8); }
        if (valid) L[j] = *(const u32x4*)(base + (size_t)(((32 * kt_j + lkey) << sh) + res_j) * DIN);
        else L[j] = (u32x4){0u, 0u, 0u, 0u};
    }
    const int res_w = (a.g < 2) ? res01 : 2 * a.blk + (wave >> 2), qt_w = (a.g < 2) ? qt0 + wave : (wave & 3);
    const bf16_t* qp = X.proj + ((size_t)a.seq * SEQ + (((32 * qt_w + r) << sh) + res_w)) * DIN + C_AQ + a.g * 512 + a.h * 64;
#pragma unroll
    for (int ks = 0; ks < 4; ++ks) qn[ks] = *(const bf16x8*)(qp + 16 * ks + 8 * hi);
}
DI void a_block_phase(const Ctx& X, LAS unsigned char* lds) {
    const int tid = X.tid, lane = tid & 63, wave = __builtin_amdgcn_readfirstlane(tid >> 6), r = lane & 31, hi = lane >> 5;
    LAS unsigned char* slots = lds + 16384;
    const int nunits = X.ch * 192;
    const int lkv = tid >> 8, lkey = (tid >> 3) & 31, lc = tid & 7;
    const int lwoff = lkv ? ((lc >> 2) * 2048 + lkey * 64 + (lc & 3) * 16) : (4096 + lkey * 144 + lc * 16);
    const int dgrp = (lane >> 4) & 1, tq = (lane & 15) >> 2, tp = lane & 3;
    const int vrd_off = (4 * hi + tq) * 64 + (16 * dgrp + 4 * tp) * 2, krd_off = 4096 + r * 144 + hi * 16;
    u32x4 L[12]; bf16x8 qn[4];
    int ub = X.bid;
    if (ub < nunits) { const AUnit a = a_decode(ub); a_issue(X, a, wave, lkv, lkey, lc, r, hi, L, qn); }
    while (ub < nunits) {
        const AUnit a = a_decode(ub);
        __syncthreads();
#pragma unroll
        for (int j = 0; j < 12; ++j) *(LAS u32x4*)(slots + j * A_SLOT + lwoff) = L[j];
        bf16x8 qf[4];
#pragma unroll
        for (int ks = 0; ks < 4; ++ks) qf[ks] = qn[ks];
        __syncthreads();
        const int ubn = ub + X.G;
        if (ubn < nunits) { const AUnit an = a_decode(ubn); a_issue(X, an, wave, lkv, lkey, lc, r, hi, L, qn); }
        const int sh = 2 * a.g, T = 64 >> sh;
        const int res01 = (a.g == 0) ? 0 : (a.blk >> 1), qt0 = (a.g == 0) ? 8 * a.blk : 8 * (a.blk & 1);
        const int res_w = (a.g < 2) ? res01 : 2 * a.blk + (wave >> 2), qt_w = (a.g < 2) ? qt0 + wave : (wave & 3);
        const int ktbase = (a.g < 2) ? qt0 - 2 : -4 * (wave >> 2);
        const int kt0 = (qt_w - 2) < 0 ? 0 : (qt_w - 2), kt1 = (qt_w + 2) > (T - 1) ? (T - 1) : (qt_w + 2);
        const float slope = fexp2(-(float)(a.g * 8 + a.h + 1) * (1.0f / 3.0f));
        const float c1 = 0.125f * LOG2E, c2 = slope * (float)(1 << sh) * LOG2E;
        f32x16 o[2]; float m = -1e30f, l = 0.f;
#pragma unroll
        for (int d = 0; d < 2; ++d)
#pragma unroll
            for (int i = 0; i < 16; ++i) o[d][i] = 0.f;
        const float dl = (float)(4 * hi - r);
        const f32x16 cfv = {0.f, 1.f, 2.f, 3.f, 8.f, 9.f, 10.f, 11.f, 16.f, 17.f, 18.f, 19.f, 24.f, 25.f, 26.f, 27.f};
        for (int kt = kt0; kt <= kt1; ++kt) {
            LAS unsigned char* sl = slots + (kt - ktbase) * A_SLOT;
            const int dlt = kt - qt_w;
            if (dlt == 0) {
                tile_compute<64>(sl + krd_off, sl + vrd_off, qf, [=](f32x16& s) {
                    const f32x16 dv = cfv + dl;
#pragma unroll
                    for (int i = 0; i < 16; ++i) s[i] = fmaf(s[i], c1, -c2 * fabsf(dv[i])); }, o, m, l);
            } else {
                const float B = (dlt > 0) ? -c2 : c2, A = -c2 * 32.f * (float)(dlt > 0 ? dlt : -dlt) + B * dl;
                const bool edge = (dlt == 2) || (dlt == -2);
                const float thr = edge ? -c2 * 64.5f : -3e38f;
                tile_compute<64>(sl + krd_off, sl + vrd_off, qf, [=](f32x16& s) {
                    const f32x16 bias = cfv * B + A;
                    s = s * c1 + bias;
                    if (edge) {
#pragma unroll
                        for (int i = 0; i < 16; ++i) s[i] = (bias[i] >= thr) ? s[i] : -1e30f; } }, o, m, l);
            }
        }
        l += __shfl_xor(l, 32);
        const float inv = frcp(l);
        const int tok = a.seq * SEQ + (((32 * qt_w + r) << sh) + res_w);
        bf16_t* prow = X.proj + (size_t)tok * DIN + C_AQ + a.g * 512 + a.h * 64;
#pragma unroll
        for (int d = 0; d < 2; ++d)
#pragma unroll
            for (int gq = 0; gq < 4; ++gq) {
                const int d0 = 32 * d + 8 * gq + 4 * hi;
                u32x2 w; w.x = pk2(o[d][4 * gq] * inv, o[d][4 * gq + 1] * inv); w.y = pk2(o[d][4 * gq + 2] * inv, o[d][4 * gq + 3] * inv);
                *(u32x2*)(prow + d0) = w;
            }
        if (hi == 0) X.lse[(size_t)tok * 24 + a.g * 8 + a.h] = m + __builtin_amdgcn_logf(l);
        ub = ubn;
    }
    __syncthreads();
}

constexpr int M_SLOT = 16896;
DI void m_block_phase(const Ctx& X, int chunk, LAS unsigned char* lds) {
    const int tid = X.tid, lane = tid & 63, wave = __builtin_amdgcn_readfirstlane(tid >> 6), r = lane & 31, hi = lane >> 5;
    LAS unsigned char* slots = lds + 16384;
    const int nunits = X.ch * 16;
    const int lkey = tid >> 4, lc = tid & 15;
    const int kwoff = 8192 + lkey * 272 + lc * 16, vwoff = (lc >> 2) * 2048 + lkey * 64 + (lc & 3) * 16;
    const int dgrp = (lane >> 4) & 1, tq = (lane & 15) >> 2, tp = lane & 3;
    const int vrd_off = (4 * hi + tq) * 64 + (16 * dgrp + 4 * tp) * 2, krd_off = 8192 + r * 272 + hi * 16;
    const float c1 = 0.08838834764831845f * LOG2E;
    for (int um = X.bid; um < nunits; um += X.G) {
        const int seq = um >> 4, h = (um >> 2) & 3, pair = um & 3;
        const int gseq = chunk * X.ch + seq;
        const bf16_t* kb = X.memkv + (size_t)gseq * NMEM * DM + h * 128 + 8 * lc;
        __syncthreads();
        {
            u32x4 LK[8], LV[8];
#pragma unroll
            for (int j = 0; j < 8; ++j) { const bf16_t* p = kb + (size_t)(32 * j + lkey) * DM; LK[j] = *(const u32x4*)p; LV[j] = *(const u32x4*)(p + 512); }
#pragma unroll
            for (int j = 0; j < 8; ++j) { *(LAS u32x4*)(slots + j * M_SLOT + kwoff) = LK[j]; *(LAS u32x4*)(slots + j * M_SLOT + vwoff) = LV[j]; }
        }
        __syncthreads();
        for (int rep = 0; rep < 2; ++rep) {
            const int tok = seq * SEQ + ((2 * pair + rep) * 8 + wave) * 32 + r;
            bf16_t* prow = X.proj + (size_t)tok * DIN;
            bf16x8 qf[8];
#pragma unroll
            for (int ks = 0; ks < 8; ++ks) qf[ks] = *(const bf16x8*)(prow + C_MQ + h * 128 + 16 * ks + 8 * hi);
            f32x16 o[4]; float m = -1e30f, l = 0.f;
#pragma unroll
            for (int d = 0; d < 4; ++d)
#pragma unroll
                for (int i = 0; i < 16; ++i) o[d][i] = 0.f;
            for (int t = 0; t < 8; t += 2) {
                LAS unsigned char* sa_ = slots + t * M_SLOT; LAS unsigned char* sb_ = sa_ + M_SLOT;
                tile_compute2<128>(sa_ + krd_off, sa_ + vrd_off, sb_ + krd_off, sb_ + vrd_off, qf, [c1](f32x16& s) { s = s * c1; }, [c1](f32x16& s) { s = s * c1; }, o, m, l);
            }
            l += __shfl_xor(l, 32);
            const float inv = frcp(l);
#pragma unroll
            for (int d = 0; d < 4; ++d)
#pragma unroll
                for (int gq = 0; gq < 4; ++gq) {
                    const int d0 = 32 * d + 8 * gq + 4 * hi;
                    const u32x2 gt = *(const u32x2*)(prow + C_MG + h * 128 + d0);
                    u32x2 w; w.x = pk2(o[d][4 * gq] * inv * siluf_(bf_lo(gt.x)), o[d][4 * gq + 1] * inv * siluf_(bf_hi(gt.x)));
                    w.y = pk2(o[d][4 * gq + 2] * inv * siluf_(bf_lo(gt.y)), o[d][4 * gq + 3] * inv * siluf_(bf_hi(gt.y)));
                    *(u32x2*)(prow + C_MQ + h * 128 + d0) = w;
                }
        }
    }
    __syncthreads();
}

struct BUnit { int seq, h, rp, cb, krlo, nt, kstart; };
DI BUnit b_decode(int u) {
    BUnit b; b.seq = u >> 9; const int rem = u & 511; b.h = rem >> 6; const int pt = rem & 63; b.rp = pt >> 2; b.cb = pt & 3;
    const int ra = 2 * b.rp - 4, rb = 2 * b.rp - 3;
    b.krlo = ra < 0 ? 0 : (ra > 24 ? 24 : ra); const int krhi = (rb < 0 ? 0 : (rb > 24 ? 24 : rb)) + 7; b.nt = krhi - b.krlo + 1;
    const int sc0 = 16 * b.cb - 8; const int k0 = sc0 < 0 ? 0 : (sc0 > 48 ? 48 : sc0); b.kstart = k0 > 32 ? 32 : k0;
    return b;
}
DI void b_stream_phase(const Ctx& X, LAS unsigned char* vimg, const LAS float* rpb_lds, int gw, int nw, int nB) {
    const int lane = X.tid & 63, r = lane & 31, hi = lane >> 5;
    constexpr int KSTR = 144;
    LAS unsigned char* kimg = vimg + 4096;
    const int vkey = lane >> 3, vc = lane & 7;
    LAS unsigned char* vwr = vimg + (vc >> 2) * 2048 + vkey * 64 + (vc & 3) * 16;
    LAS unsigned char* kwr = kimg + vkey * KSTR + vc * 16;
    const LAS unsigned char* krd = kimg + r * KSTR + hi * 16;
    const int dgrp = (lane >> 4) & 1, tq = (lane & 15) >> 2, tp = lane & 3;
    LAS unsigned char* vrd = vimg + (4 * hi + tq) * 64 + (16 * dgrp + 4 * tp) * 2;
    const float c1 = 0.125f * LOG2E;
    int u = gw; if (u >= nB) return;
    BUnit cu = b_decode(u);
    int pu = u, ptile = 0; BUnit pb = cu;
    u32x4 kk[2][4], vv[2][4];
#define B_PF(J) do { if (pu < nB) { const bf16_t* _kb = X.proj + ((size_t)pb.seq * SEQ + (pb.krlo + ptile) * 64 + pb.kstart + vkey) * DIN + C_BK + pb.h * 64 + 8 * vc; \
        _Pragma("unroll") for (int i = 0; i < 4; ++i) { kk[J][i] = *(const u32x4*)(_kb + (size_t)(8 * i) * DIN); vv[J][i] = *(const u32x4*)(_kb + (size_t)(8 * i) * DIN + (C_BV - C_BK)); } \
        if (++ptile == pb.nt) { pu += nw; ptile = 0; if (pu < nB) pb = b_decode(pu); } } } while (0)
    B_PF(0); B_PF(1);
    bf16x8 qf[4], qn[4]; u32x2 gg[8];
    int qr, qc, dcb; float fl;
#define B_LANE(b) do { qr = 2 * (b).rp + (r >> 4); qc = 16 * (b).cb + (r & 15); \
        const int _scq = (qc - 8) < 0 ? 0 : ((qc - 8) > 48 ? 48 : (qc - 8)); fl = (float)(4 * hi - (_scq - (b).kstart)) - 7.5f; dcb = (b).kstart - qc + 31 + 4 * hi; } while (0)
#define B_PROW(b) (X.proj + ((size_t)(b).seq * SEQ + qr * 64 + qc) * DIN)
#define B_Q(b, Q) do { const int _qr = 2 * (b).rp + (r >> 4), _qc = 16 * (b).cb + (r & 15); const bf16_t* _p = X.proj + ((size_t)(b).seq * SEQ + _qr * 64 + _qc) * DIN; \
        _Pragma("unroll") for (int ks = 0; ks < 4; ++ks) Q[ks] = *(const bf16x8*)(_p + C_BQ + (b).h * 64 + 16 * ks + 8 * hi); } while (0)
#define B_G(b) do { _Pragma("unroll") for (int d = 0; d < 2; ++d) _Pragma("unroll") for (int gq = 0; gq < 4; ++gq) gg[d * 4 + gq] = *(const u32x2*)(B_PROW(b) + C_BG + (b).h * 64 + 32 * d + 8 * gq + 4 * hi); } while (0)
    B_LANE(cu); B_Q(cu, qf); B_G(cu);
    { const int nu = u + nw; if (nu < nB) { const BUnit nb = b_decode(nu); B_Q(nb, qn); } }
    f32x16 o[2]; float m = -1e30f, l = 0.f; int t = 0;
#pragma unroll
    for (int d = 0; d < 2; ++d)
#pragma unroll
        for (int i = 0; i < 16; ++i) o[d][i] = 0.f;
    bool done = false;
#define B_STEP(J) do { \
        _Pragma("unroll") for (int i = 0; i < 4; ++i) { *(LAS u32x4*)(kwr + i * 8 * KSTR) = kk[J][i]; *(LAS u32x4*)(vwr + i * 8 * 64) = vv[J][i]; } \
        asm volatile("" ::: "memory"); \
        B_PF(J); \
        { const int kr = cu.krlo + t; const int r0q = (qr - 4) < 0 ? 0 : ((qr - 4) > 24 ? 24 : (qr - 4)); const bool rowok = (kr >= r0q) && (kr <= r0q + 7); int dr = kr - qr + 7; dr = dr < 0 ? 0 : (dr > 14 ? 14 : dr); \
          const LAS float* bp = rpb_lds + cu.h * (15 * 64) + dr * 64 + dcb; const float flt = rowok ? fl : 1e9f; \
          f32x16 bb; BLD(0, 0) BLD(1, 1) BLD(2, 2) BLD(3, 3) BLD(4, 8) BLD(5, 9) BLD(6, 10) BLD(7, 11) BLD(8, 16) BLD(9, 17) BLD(10, 18) BLD(11, 19) BLD(12, 24) BLD(13, 25) BLD(14, 26) BLD(15, 27) \
          asm volatile("" : "+v"(bb)); \
          tile_compute<64>(krd, vrd, qf, [=](f32x16& s) { \
              BEL(0, 0) BEL(1, 1) BEL(2, 2) BEL(3, 3) BEL(4, 8) BEL(5, 9) BEL(6, 10) BEL(7, 11) BEL(8, 16) BEL(9, 17) BEL(10, 18) BEL(11, 19) BEL(12, 24) BEL(13, 25) BEL(14, 26) BEL(15, 27) }, o, m, l); } \
        asm volatile("" ::: "memory"); \
        if (++t == cu.nt) { \
            l += __shfl_xor(l, 32); const float inv = frcp(l); bf16_t* prow = B_PROW(cu); \
            _Pragma("unroll") for (int d = 0; d < 2; ++d) _Pragma("unroll") for (int gq = 0; gq < 4; ++gq) { const u32x2 gt = gg[d * 4 + gq]; u32x2 w; \
                w.x = pk2(o[d][4 * gq] * inv * siluf_(bf_lo(gt.x)), o[d][4 * gq + 1] * inv * siluf_(bf_hi(gt.x))); \
                w.y = pk2(o[d][4 * gq + 2] * inv * siluf_(bf_lo(gt.y)), o[d][4 * gq + 3] * inv * siluf_(bf_hi(gt.y))); \
                *(u32x2*)(prow + C_BQ + cu.h * 64 + 32 * d + 8 * gq + 4 * hi) = w; } \
            u += nw; \
            if (u >= nB) done = true; \
            else { cu = b_decode(u); B_LANE(cu); \
                _Pragma("unroll") for (int ks = 0; ks < 4; ++ks) qf[ks] = qn[ks]; \
                B_G(cu); \
                { const int nu = u + nw; if (nu < nB) { const BUnit nb = b_decode(nu); B_Q(nb, qn); } } \
                m = -1e30f; l = 0.f; t = 0; \
                _Pragma("unroll") for (int d = 0; d < 2; ++d) _Pragma("unroll") for (int i = 0; i < 16; ++i) o[d][i] = 0.f; } } } while (0)
#define BLD(i, CF) bb[i] = bp[CF];
#define BEL(i, CF) { const float tt = (float)(CF) + flt; s[i] = (fabsf(tt) <= 7.5f) ? fmaf(s[i], c1, bb[i]) : -1e30f; }
    for (;;) {
        B_STEP(0); if (done) break;
        B_STEP(1); if (done) break;
    }
#undef BEL
#undef BLD
#undef B_STEP
#undef B_Q
#undef B_G
#undef B_LANE
#undef B_PROW
#undef B_PF
}

DI void phase_attn(const Ctx& X0, int chunk, LAS unsigned char* lds, int dry) {
    Ctx X = X0; X.bid = (X0.G % 8 == 0) ? (X0.bid % 8) * (X0.G / 8) + X0.bid / 8 : X0.bid;
    const int tid = X.tid, wave = __builtin_amdgcn_readfirstlane(tid >> 6);
    LAS float* rp = (LAS float*)lds;
    for (int i = tid; i < 8 * 15 * 64; i += 512) { const int col = i & 63, hr = i >> 6;
        rp[i] = (col >= 16 && col <= 46) ? X.in[8][hr * 31 + (col - 16)] * LOG2E : 0.f; }
    __syncthreads();
    LAS unsigned char* vimg = lds + 32768 + wave * 8704;
    const int gw = X.bid * 8 + wave, nw = X.G * 8;
    const int nB = X.ch * 512;
    b_stream_phase(X, vimg, rp, gw, nw, nB);
    __syncthreads();
    { Ctx X2 = X; int t2 = X.tid; asm volatile("" : "+v"(t2)); X2.tid = t2; m_block_phase(X2, chunk, lds); }
    { Ctx X3 = X; int t3 = X.tid; asm volatile("" : "+v"(t3)); X3.tid = t3; a_block_phase(X3, lds); }
    __syncthreads();
}

DI void phase_combine(const Ctx& X, int chunk, int nchunk) {
    const int lane = X.tid & 63, wave = __builtin_amdgcn_readfirstlane(X.tid >> 6);
    const int gw = X.bid * 8 + wave, nw = X.G * 8, ntok = X.ch * SEQ;
    const int h = lane >> 3;
    for (int t0 = gw; t0 < ntok; t0 += 4 * nw) {
        u32x4 a[4], b[4], c[4], gt[4]; float l0[4], l1[4], l2[4];
#pragma unroll
        for (int u = 0; u < 4; ++u) { const int t = (t0 + u * nw < ntok) ? t0 + u * nw : t0; const bf16_t* prow = X.proj + (size_t)t * DIN;
            l0[u] = X.lse[(size_t)t * 24 + h]; l1[u] = X.lse[(size_t)t * 24 + 8 + h]; l2[u] = X.lse[(size_t)t * 24 + 16 + h];
            a[u] = *(const u32x4*)(prow + 8 * lane); b[u] = *(const u32x4*)(prow + 512 + 8 * lane); c[u] = *(const u32x4*)(prow + 1024 + 8 * lane);
            gt[u] = *(const u32x4*)(prow + C_AG + 8 * lane); }
#pragma unroll
        for (int u = 0; u < 4; ++u) { const int t = t0 + u * nw;
            const float mx = fmaxf(l0[u], fmaxf(l1[u], l2[u]));
            float w0 = fexp2(l0[u] - mx), w1 = fexp2(l1[u] - mx), w2 = fexp2(l2[u] - mx);
            const float inv = frcp(w0 + w1 + w2); w0 *= inv; w1 *= inv; w2 *= inv;
            u32x4 w;
#define CMB(f) pk2((w0 * bf_lo(a[u].f) + w1 * bf_lo(b[u].f) + w2 * bf_lo(c[u].f)) * siluf_(bf_lo(gt[u].f)), (w0 * bf_hi(a[u].f) + w1 * bf_hi(b[u].f) + w2 * bf_hi(c[u].f)) * siluf_(bf_hi(gt[u].f)))
            w.x = CMB(x); w.y = CMB(y); w.z = CMB(z); w.w = CMB(w);
#undef CMB
            if (t < ntok) *(u32x4*)(X.proj + (size_t)t * DIN + 8 * lane) = w; }
    }
    if (chunk + 1 < nchunk) rms_tokens(X.in[0], X.in[1], X.in[4], X.hn, (chunk + 1) * ntok, ntok, gw, nw, X.tid);
}

#define XB_TMO      128
#define XB_XCNT(j)  (256  + 64 * (j))
#define XB_XSUB(j)  (1280 + 64 * (j))
#define XB_XGEN(j)  (2304 + 64 * (j))
#define XB_TOP      3328
#define XB_TOPGEN   3392
#define XCD_BAR_WORDS 3456
#define XB_SPIN_CAP (1u << 20)
DI unsigned xb_ld(unsigned* p) { return __hip_atomic_load(p, __ATOMIC_RELAXED, __HIP_MEMORY_SCOPE_AGENT); }
DI unsigned xb_add(unsigned* p, unsigned v) { return __hip_atomic_fetch_add(p, v, __ATOMIC_RELAXED, __HIP_MEMORY_SCOPE_AGENT); }
DI unsigned xb_xcc_id() { return (unsigned)__builtin_amdgcn_s_getreg((3 << 11) | 20) & 0xFu; }
#define XB_SPIN(cond, bar) do { unsigned _sp = 0; while (cond) { __builtin_amdgcn_s_sleep(1); \
    if ((++_sp & 255u) == 0u) { if (xb_ld(&(bar)[XB_TMO])) break; if (_sp > XB_SPIN_CAP) { atomicAdd(&(bar)[XB_TMO], 1u); break; } } } } while (0)
DI void xcd_barrier_complete(unsigned* bar, unsigned x, unsigned& nloc, unsigned& nx) {
    const unsigned G = gridDim.x;
    unsigned sum, cnt, mine, sp = 0u;
    for (;;) {
        sum = 0u; cnt = 0u; mine = 0u;
#pragma unroll
        for (unsigned j = 0; j < 16; ++j) { const unsigned c = xb_ld(&bar[XB_XCNT(j)]); sum += c; cnt += (c > 0u) ? 1u : 0u; mine = (j == x) ? c : mine; }
        if (sum == G) break;
        __builtin_amdgcn_s_sleep(1);
        if ((++sp & 255u) == 0u) { if (xb_ld(&bar[XB_TMO])) break; if (sp > XB_SPIN_CAP) { atomicAdd(&bar[XB_TMO], 1u); break; } }
    }
    nloc = mine > 0u ? mine : 1u; nx = cnt > 0u ? cnt : 1u;
}
DI void xcd_barrier(unsigned* bar, volatile LAS unsigned* st) {
    asm volatile("s_waitcnt vmcnt(0)" ::: "memory");
    __syncthreads();
    if (threadIdx.x == 0) {
        __builtin_amdgcn_s_waitcnt(0);
        const unsigned x = xb_xcc_id();
        unsigned nloc = st[0], nx = st[1];
        if (nloc == 0u) { xcd_barrier_complete(bar, x, nloc, nx); st[0] = nloc; st[1] = nx; }
        const unsigned old = xb_add(&bar[XB_XSUB(x)], 1u);
        const unsigned gen = old / nloc;
        if (old + 1u == (gen + 1u) * nloc) {
            __builtin_amdgcn_fence(__ATOMIC_RELEASE, "agent");
            asm volatile("s_waitcnt vmcnt(0)" ::: "memory");
            const unsigned og = xb_add(&bar[XB_TOP], 1u);
            const unsigned tg = og / nx;
            if (og + 1u == (tg + 1u) * nx) xb_add(&bar[XB_TOPGEN], 1u);
            else XB_SPIN(xb_ld(&bar[XB_TOPGEN]) == tg, bar);
            __builtin_amdgcn_fence(__ATOMIC_ACQUIRE, "agent");
            xb_add(&bar[XB_XGEN(x)], 1u);
            asm volatile("s_waitcnt vmcnt(0)" ::: "memory");
        } else {
            XB_SPIN(xb_ld(&bar[XB_XGEN(x)]) == gen, bar);
            __builtin_amdgcn_fence(__ATOMIC_ACQUIRE, "agent");
            asm volatile("s_waitcnt vmcnt(0)" ::: "memory");
        }
    }
    __syncthreads();
}

__global__ void __launch_bounds__(512, 2) mega(Args a) {
    extern __shared__ __attribute__((aligned(16))) unsigned char lds_raw[];
    LAS unsigned char* lds = (LAS unsigned char*)lds_raw;
    typedef const Args __attribute__((address_space(4))) * KArgP;
    KArgP ap0 = (KArgP)__builtin_amdgcn_kernarg_segment_ptr();
    const int step_lo = ap0->step_lo, step_hi = ap0->step_hi;
    volatile LAS unsigned* bst = (volatile LAS unsigned*)(lds + LDS_PHASE);
    if (threadIdx.x == 0) { bst[0] = 0u; bst[1] = 0u; }
    __syncthreads();
    for (int step = step_lo; step < step_hi; ++step) {
        KArgP ap = ap0; asm volatile("" : "+s"(ap));
        int tid_ = threadIdx.x; asm volatile("" : "+v"(tid_));
        int bid_ = blockIdx.x; asm volatile("" : "+s"(bid_));
        Ctx X;
#pragma unroll
        for (int i = 0; i < 14; ++i) X.in[i] = ap->in[i];
        unsigned char* const ws = ap->ws; const int ch = ap->ch, nchunk = ap->nchunk, coop = ap->coop;
        X.out = ap->out; X.ws = ws; X.ch = ch; X.G = gridDim.x; X.tid = tid_; X.bid = bid_;
        X.win_t = (bf16_t*)(ws + OFF_WIN); X.wkv_t = (bf16_t*)(ws + OFF_WKV); X.wp_t = (bf16_t*)(ws + OFF_WP); X.wout_t = (bf16_t*)(ws + OFF_WOUT);
        X.hn = (bf16_t*)(ws + OFF_DYN); X.memh = (bf16_t*)(ws + OFF_MEMH); X.memkv = (bf16_t*)(ws + OFF_MEMKV); X.ssq = (float*)(ws + OFF_SSQ);
        X.proj = (bf16_t*)(ws + OFF_DYN + hn_bytes(ch)); X.merged = (bf16_t*)(ws + OFF_DYN + hn_bytes(ch) + proj_bytes(ch)); X.lse = (float*)(ws + OFF_DYN + hn_bytes(ch) + proj_bytes(ch) + merged_bytes(ch));
        const int Mc = ch * SEQ;
        bool sync_after = true;
        if (step == 0) {
            if (bid_ == 0) for (int i = tid_; i < XCD_BAR_WORDS + (int)((OFF_DYN - OFF_PCNT) / 4) + (16384 / 4 - XCD_BAR_WORDS); i += 512) __hip_atomic_store((unsigned*)(ws + OFF_CTR) + i, 0u, __ATOMIC_RELAXED, __HIP_MEMORY_SCOPE_AGENT);
            phase_p0(X, lds);
        } else {
            const int chunk = (step - 1) / 5, k = (step - 1) % 5;
            if (k == 0) {
                if (chunk == 0) {
                    pg8::Gemm g{X.memh, X.wkv_t, DM, DM, DM, 0, 0, 0, 0}; pg8::StaticOrder S; S.init(NSEQ * NMEM, DM, 1, X.G, X.bid);
                    pg8::EpiBf16 E{X.memkv, DM};
                    pg8::gemm_phase<pg8::EpiBf16, pg8::StaticOrder>(lds, g, S, E, X.tid);
                }
                pg8::Gemm g{X.hn, X.win_t, DM, DM, DM, 0, 0, 0, 0}; pg8::StaticOrder S; S.init(Mc, DIN, 1, X.G, X.bid, P1_WGM);
                pg8::EpiBf16 E{X.proj, DIN};
#if PROBE == 1
                for (int rep = 0; rep < 2; ++rep)
#endif
                pg8::gemm_phase<pg8::EpiBf16, pg8::StaticOrder>(lds, g, S, E, X.tid);
            } else if (k == 1) {
#if PROBE == 2
                for (int rep = 0; rep < 2; ++rep) { int dry = 1 - rep; asm volatile("" : "+s"(dry)); phase_attn(X, chunk, lds, dry); }
#else
                phase_attn(X, chunk, lds, 0);
#endif
            } else if (k == 2) {
                phase_combine(X, chunk, nchunk);
            } else if (k == 3) {
                pg8::Gemm g{X.proj, X.wp_t, 512, DIN, 512, C_AQ, C_BQ, C_MQ, (size_t)1024 * 512}; pg8::StaticOrder S; S.init(Mc, DM, 3, X.G, X.bid, 4);
                pg8::EpiGate E{X.proj, X.merged};
#if PROBE == 6
                { pg8::EpiBf16 E0{X.merged, DM}; pg8::gemm_phase<pg8::EpiBf16, pg8::StaticOrder>(lds, g, S, E0, X.tid); }
#endif
#if PROBE == 3
                for (int rep = 0; rep < 2; ++rep)
#endif
                pg8::gemm_phase<pg8::EpiGate, pg8::StaticOrder>(lds, g, S, E, X.tid);
            } else {
                pg8::Gemm g{X.merged, X.wout_t, DM, DM, DM, 0, 0, 0, 0}; pg8::StaticOrder S; S.init(Mc, DM, 1, X.G, X.bid, 4);
                pg8::EpiOut E{X.in[0], X.in[1], X.out, X.ssq, (unsigned*)(ws + OFF_PCNT), X.in[13], chunk * Mc, lds + 131072};
#if PROBE == 4
                for (int rep = 0; rep < 2; ++rep)
#endif
                pg8::gemm_phase<pg8::EpiOut, pg8::StaticOrder>(lds, g, S, E, X.tid);
                if (chunk + 1 < nchunk) sync_after = false;
            }
        }
        if (coop && sync_after && step + 1 < step_hi) {
            if (step == 0) { cg::this_grid().sync();
                if (threadIdx.x == 0) (void)xb_add((unsigned*)(ws + OFF_CTR) + XB_XCNT(xb_xcc_id()), 1u); }
            else xcd_barrier((unsigned*)(ws + OFF_CTR), bst);
        }
    }
}

extern "C" void kernel_launch(void* const* d_in, const int* in_sizes, int n_in, void* d_out, int out_size, void* d_ws, size_t ws_size, hipStream_t stream) {
    static int grid = 0, ch = 0, coop = 1;
    if (grid == 0) {
        int dev = 0, cus = 0, per_cu = 0;
        if (hipGetDevice(&dev) != hipSuccess || hipDeviceGetAttribute(&cus, hipDeviceAttributeMultiprocessorCount, dev) != hipSuccess) { fprintf(stderr, "kernel_launch: device query failed\n"); grid = -1; return; }
        if (hipFuncSetAttribute((const void*)mega, hipFuncAttributeMaxDynamicSharedMemorySize, LDS_BYTES) != hipSuccess) { fprintf(stderr, "kernel_launch: hipFuncSetAttribute failed\n"); grid = -1; return; }
        if (hipOccupancyMaxActiveBlocksPerMultiprocessor(&per_cu, (const void*)mega, 512, LDS_BYTES) != hipSuccess || per_cu < 1) { fprintf(stderr, "kernel_launch: occupancy query says %d\n", per_cu); per_cu = 1; }
        (void)hipGetLastError();
        grid = cus * 1;
        const int cands[8] = {16, 8, 6, 4, 3, 2, 1, 1};
        for (int i = 0; i < 8; ++i) if (ws_needed(cands[i]) <= ws_size) { ch = cands[i]; break; }
        if (ch == 0) { fprintf(stderr, "kernel_launch: workspace too small (%zu)\n", ws_size); grid = -1; return; }
        fprintf(stderr, "kernel_launch: grid %d, per_cu %d, ch %d, ws %zu\n", grid, per_cu, ch, ws_size);
    }
    if (grid < 0) return;
    Args a{};
    for (int i = 0; i < 14; ++i) a.in[i] = (const float*)d_in[i];
    a.out = (float*)d_out; a.ws = (unsigned char*)d_ws; a.ch = ch; a.nchunk = NSEQ / ch; a.pad = 0;
    const int nsteps = 1 + 5 * a.nchunk;
    if (coop) {
        a.step_lo = 0; a.step_hi = nsteps; a.coop = 1;
        void* args[] = {&a};
        hipError_t e = hipLaunchCooperativeKernel((const void*)mega, dim3(grid), dim3(512), args, LDS_BYTES, stream);
        if (e == hipSuccess) return;
        fprintf(stderr, "kernel_launch: cooperative launch failed: %s; falling back to one launch per phase\n", hipGetErrorString(e));
        (void)hipGetLastError();
        coop = 0;
    }
    for (int s = 0; s < nsteps; ++s) {
        a.step_lo = s; a.step_hi = s + 1; a.coop = 0;
        hipLaunchKernelGGL(mega, dim3(grid), dim3(512), LDS_BYTES, stream, a);
    }
}
```

```cpp
#include <hip/hip_runtime.h>
#include <hip/hip_cooperative_groups.h>
#include <cstdio>
#include <cstdint>
namespace cg = cooperative_groups;

#define LAS __attribute__((address_space(3)))
#define DI __device__ __forceinline__
typedef unsigned short bf16_t;
typedef short bf16x8 __attribute__((ext_vector_type(8)));
typedef short s16x4 __attribute__((ext_vector_type(4)));
typedef short v4i16_t __attribute__((ext_vector_type(4)));
typedef float f32x4 __attribute__((ext_vector_type(4)));
typedef float f32x16 __attribute__((ext_vector_type(16)));
typedef unsigned u32x4 __attribute__((ext_vector_type(4)));
typedef unsigned u32x2 __attribute__((ext_vector_type(2)));
typedef float f32x2_t __attribute__((ext_vector_type(2)));
typedef __bf16 bf16x2_t __attribute__((ext_vector_type(2)));

constexpr int DM = 1024, SEQ = 2048, NSEQ = 48, NTOK = NSEQ * SEQ, NPROMPT_TOK = 32 * SEQ, NMEM = 256, DIN = 11264;
constexpr int LDP = DIN + 64;
constexpr int C_AQ = 0, C_AK = 1536, C_AV = 3072, C_AG = 4608, C_BQ = 5120, C_BK = 5632, C_BV = 6144, C_BG = 6656, C_MQ = 7168, C_MG = 7680, C_MERGE = 8192;
constexpr float LOG2E = 1.4426950408889634f;
constexpr float RMS_EPS = 1e-6f;

constexpr size_t OFF_WIN = 0;
constexpr size_t OFF_WKV = OFF_WIN + (size_t)DIN * DM * 2;
constexpr size_t OFF_WP = OFF_WKV + 2097152;
constexpr size_t OFF_WOUT = OFF_WP + 3145728;
constexpr size_t OFF_MEMH = OFF_WOUT + 2097152;
constexpr size_t OFF_MEMKV = OFF_MEMH + (size_t)NSEQ * NMEM * DM * 2;
constexpr size_t OFF_SSQ = OFF_MEMKV + (size_t)NSEQ * NMEM * DM * 2;
constexpr size_t OFF_CTR = OFF_SSQ + (size_t)NTOK * 16 * 4;
constexpr size_t OFF_PCNT = OFF_CTR + 16384;
constexpr size_t OFF_DYN = OFF_PCNT + 384 * 64;
DI constexpr size_t proj_bytes(int ch) { return (size_t)ch * SEQ * LDP * 2; }
DI constexpr size_t merged_bytes(int ch) { return (size_t)ch * SEQ * DM * 2; }
DI constexpr size_t lse_bytes(int ch) { return (size_t)ch * SEQ * 24 * 4; }
DI constexpr size_t hn_bytes(int ch) { return (size_t)ch * SEQ * DM * 2; }
static size_t ws_needed(int ch) { return OFF_DYN + (size_t)ch * SEQ * DM * 2 + (size_t)ch * SEQ * LDP * 2 + (size_t)ch * SEQ * DM * 2 + (size_t)ch * SEQ * 24 * 4; }

#ifndef PROBE
#define PROBE 0
#endif
#ifndef P1_WGM
#define P1_WGM 4
#endif
constexpr int LDS_PHASE = 155648, LDS_BYTES = LDS_PHASE + 64;

struct Args { const float* in[14]; float* out; unsigned char* ws; int ch, nchunk, step_lo, step_hi, coop, pad; };

DI unsigned pk2(float lo, float hi) { f32x2_t v = {lo, hi}; bf16x2_t b = __builtin_convertvector(v, bf16x2_t); return __builtin_bit_cast(unsigned, b); }
DI float bf_lo(unsigned w) { return __uint_as_float(w << 16); }
DI float bf_hi(unsigned w) { return __uint_as_float(w & 0xffff0000u); }
DI float fexp2(float x) { return __builtin_amdgcn_exp2f(x); }
DI float frcp(float x) { return __builtin_amdgcn_rcpf(x); }
DI float sigmoidf_(float x) { return frcp(1.0f + fexp2(-x * LOG2E)); }
DI float siluf_(float x) { return x * sigmoidf_(x); }
DI float wave_sum(float v) {
#pragma unroll
    for (int o = 1; o < 64; o <<= 1) v += __shfl_xor(v, o);
    return v;
}
DI int crow(int r, int hi) { return (r & 3) + 8 * (r >> 2) + 4 * hi; }

namespace pg8 {
constexpr int BM = 256, BK = 64, HALF = 128, HTB = HALF * BK * 2, STAGE_BYTES = 8 * HTB, NXCD = 8, WGM = 8;
DI int lds_byte(int r, int c) { const int st = (r >> 4) * 2 + (c >> 5), rr = r & 15, cc = c & 31, ob = rr * 64 + cc * 2; return st * 1024 + (ob ^ (((ob >> 9) & 1) << 5)); }
DI void stage_rc(int b, int& R, int& C) { const int st = b / 1024, sb = b % 1024, swz = sb ^ (((sb >> 9) & 1) << 5); R = (st >> 1) * 16 + swz / 64; C = (st & 1) * 32 + (swz % 64) / 2; }
DI int perm32(int rho) { const int n = rho >> 4, i = rho & 15; return 8 * (i >> 2) + 4 * n + (i & 3); }

struct Unit { int pm, pn, z; };
struct Gemm { const bf16_t* A; const bf16_t* Bt; int K, lda, ldb, a0, a1, a2; size_t zB; };

struct StaticOrder {
    int nM, nN, nwg, G, c, nz, wgm;
    DI void init(int M, int N, int nz_, int G_, int c_, int wgm_ = WGM) { nM = M / BM; nN = N / BM; nwg = nM * nN; G = G_; c = c_; nz = nz_; wgm = wgm_; }
    DI bool next(int i, Unit& u) const {
        const int it = i / nz; u.z = i - it * nz;
        const long L = (long)it * G + c; if (L >= nwg) return false;
        int wgid = (int)L; { const int q = nwg / NXCD, r = nwg % NXCD, xcd = wgid % NXCD, off = wgid / NXCD; wgid = (xcd < r ? xcd * (q + 1) : r * (q + 1) + (xcd - r) * q) + off; }
        const int nig = wgm * nN, gid = wgid / nig, fm = gid * wgm, gsz = (nM - fm) < wgm ? (nM - fm) : wgm;
        u.pm = fm + ((wgid % nig) % gsz); u.pn = (wgid % nig) / gsz; return true;
    }
};

struct EpiBf16 {
    static constexpr bool PERM = true;
    bf16_t* O; int ldc;
    DI void operator()(f32x4 (&acc)[2][2][4][2], const Unit& u, int wr, int wc, int fr, int fq) const {
        const int row0 = u.pm * BM + wr * 64 + fr; const int col0 = u.pn * BM + wc * 32 + 8 * fq;
#pragma unroll
        for (int ai = 0; ai < 2; ++ai)
#pragma unroll
            for (int m = 0; m < 4; ++m) { bf16_t* rowp = O + (size_t)(row0 + ai * HALF + m * 16) * ldc + col0;
#pragma unroll
                for (int bj = 0; bj < 2; ++bj) { const f32x4 v0 = acc[ai][bj][m][0], v1 = acc[ai][bj][m][1];
                    u32x4 w; w.x = pk2(v0[0], v0[1]); w.y = pk2(v0[2], v0[3]); w.z = pk2(v1[0], v1[1]); w.w = pk2(v1[2], v1[3]);
                    *(u32x4*)(rowp + bj * HALF) = w; } }
    }
};
struct EpiGate {
    static constexpr bool PERM = true;
    const bf16_t* proj; bf16_t* merged;
    DI void operator()(f32x4 (&acc)[2][2][4][2], const Unit& u, int wr, int wc, int fr, int fq) const {
        const int row0 = u.pm * BM + wr * 64 + fr; const int col0 = u.pn * BM + wc * 32 + 8 * fq;
        const bool rmw = (u.z != 0);
#pragma unroll
        for (int ai = 0; ai < 2; ++ai) {
            u32x4 gw[4][2], ov[4][2];
#pragma unroll
            for (int m = 0; m < 4; ++m)
#pragma unroll
                for (int bj = 0; bj < 2; ++bj) { const size_t row = (size_t)(row0 + ai * HALF + m * 16); const int col = col0 + bj * HALF;
                    gw[m][bj] = *(const u32x4*)(proj + row * LDP + C_MERGE + u.z * DM + col);
                    ov[m][bj] = rmw ? *(const u32x4*)(merged + row * DM + col) : (u32x4){0u, 0u, 0u, 0u}; }
            asm volatile("" ::: "memory");
#pragma unroll
            for (int m = 0; m < 4; ++m)
#pragma unroll
                for (int bj = 0; bj < 2; ++bj) { const size_t row = (size_t)(row0 + ai * HALF + m * 16); const int col = col0 + bj * HALF;
                    const f32x4 v0 = acc[ai][bj][m][0], v1 = acc[ai][bj][m][1]; const u32x4 g = gw[m][bj], o = ov[m][bj];
                    const float r0 = sigmoidf_(bf_lo(g.x)) * v0[0] + bf_lo(o.x), r1 = sigmoidf_(bf_hi(g.x)) * v0[1] + bf_hi(o.x), r2 = sigmoidf_(bf_lo(g.y)) * v0[2] + bf_lo(o.y), r3 = sigmoidf_(bf_hi(g.y)) * v0[3] + bf_hi(o.y);
                    const float r4 = sigmoidf_(bf_lo(g.z)) * v1[0] + bf_lo(o.z), r5 = sigmoidf_(bf_hi(g.z)) * v1[1] + bf_hi(o.z), r6 = sigmoidf_(bf_lo(g.w)) * v1[2] + bf_lo(o.w), r7 = sigmoidf_(bf_hi(g.w)) * v1[3] + bf_hi(o.w);
                    u32x4 w; w.x = pk2(r0, r1); w.y = pk2(r2, r3); w.z = pk2(r4, r5); w.w = pk2(r6, r7);
                    *(u32x4*)(merged + row * DM + col) = w; }
        }
    }
};
struct EpiOut {
    static constexpr bool PERM = true;
    const float* xp; const float* xs; float* out; float* xbuf; unsigned* cnt; const float* gain; int tok0; LAS unsigned char* lds_x;
    DI void operator()(f32x4 (&acc)[2][2][4][2], const Unit& u, int wr, int wc, int fr, int fq) const {
        const int row0 = u.pm * BM + wr * 64 + fr; const int col0 = u.pn * BM + wc * 32 + 8 * fq;
        const int tg0 = tok0 + row0;
        const float* xb = (tg0 < NPROMPT_TOK) ? xp + (size_t)tg0 * DM : xs + (size_t)(tg0 - NPROMPT_TOK) * DM;
        LAS float* part = (LAS float*)lds_x;
        LAS float* scl = (LAS float*)(lds_x + 4096);
        volatile LAS unsigned* flag = (volatile LAS unsigned*)(lds_x + 4096 + 1024);
#pragma unroll
        for (int ai = 0; ai < 2; ++ai) {
            f32x4 xv[4][2][2];
#pragma unroll
            for (int m = 0; m < 4; ++m)
#pragma unroll
                for (int bj = 0; bj < 2; ++bj) { const float* xr = xb + (size_t)(ai * HALF + m * 16) * DM + col0 + bj * HALF;
                    xv[m][bj][0] = *(const f32x4*)xr; xv[m][bj][1] = *(const f32x4*)(xr + 4); }
            asm volatile("" ::: "memory");
#pragma unroll
            for (int m = 0; m < 4; ++m) { float sq = 0.f;
#pragma unroll
                for (int bj = 0; bj < 2; ++bj) {
                    const f32x4 y0 = xv[m][bj][0] + acc[ai][bj][m][0], y1 = xv[m][bj][1] + acc[ai][bj][m][1];
                    sq += (y0[0] * y0[0] + y0[1] * y0[1]) + (y0[2] * y0[2] + y0[3] * y0[3]) + (y1[0] * y1[0] + y1[1] * y1[1]) + (y1[2] * y1[2] + y1[3] * y1[3]);
                    acc[ai][bj][m][0] = y0; acc[ai][bj][m][1] = y1; }
                sq += __shfl_xor(sq, 16); sq += __shfl_xor(sq, 32);
                if (fq == 0) part[(ai * HALF + wr * 64 + m * 16 + fr) * 4 + wc] = sq; }
        }
        __syncthreads();
        const int tid = threadIdx.x; const int panel = (tok0 >> 8) + u.pm;
        if (tid < 256) { const float t4 = (part[tid * 4] + part[tid * 4 + 1]) + (part[tid * 4 + 2] + part[tid * 4 + 3]);
            __hip_atomic_store(xbuf + ((size_t)(tok0 + u.pm * BM + tid)) * 4 + u.pn, t4, __ATOMIC_RELAXED, __HIP_MEMORY_SCOPE_AGENT); }
        asm volatile("s_waitcnt vmcnt(0)" ::: "memory");
        __syncthreads();
        if (tid < 64) {
            if (tid == 0) __hip_atomic_fetch_add(cnt + 16 * panel, 1u, __ATOMIC_RELAXED, __HIP_MEMORY_SCOPE_AGENT);
            unsigned sp = 0;
            while ((unsigned)__builtin_amdgcn_readfirstlane(__hip_atomic_load(cnt + 16 * panel, __ATOMIC_RELAXED, __HIP_MEMORY_SCOPE_AGENT)) < 4u) { __builtin_amdgcn_s_sleep(2); if (++sp > (1u << 22)) break; }
            if (tid == 0) flag[0] = 1u;
        }
        __syncthreads();
        if (tid < 256) { const float* xp4 = xbuf + ((size_t)(tok0 + u.pm * BM + tid)) * 4;
            const float a = __hip_atomic_load(xp4, __ATOMIC_RELAXED, __HIP_MEMORY_SCOPE_AGENT), b = __hip_atomic_load(xp4 + 1, __ATOMIC_RELAXED, __HIP_MEMORY_SCOPE_AGENT);
            const float c = __hip_atomic_load(xp4 + 2, __ATOMIC_RELAXED, __HIP_MEMORY_SCOPE_AGENT), d = __hip_atomic_load(xp4 + 3, __ATOMIC_RELAXED, __HIP_MEMORY_SCOPE_AGENT);
            scl[tid] = __builtin_amdgcn_rsqf(((a + b) + (c + d)) * (1.0f / DM) + RMS_EPS); }
        __syncthreads();
        f32x4 gv[2][2];
#pragma unroll
        for (int bj = 0; bj < 2; ++bj) { gv[bj][0] = *(const f32x4*)(gain + col0 + bj * HALF); gv[bj][1] = *(const f32x4*)(gain + col0 + bj * HALF + 4); }
#pragma unroll
        for (int ai = 0; ai < 2; ++ai)
#pragma unroll
            for (int m = 0; m < 4; ++m) { const int rl = ai * HALF + wr * 64 + m * 16 + fr; const float sc = scl[rl];
                float* orow = out + (size_t)(tok0 + u.pm * BM + rl) * DM;
#pragma unroll
                for (int bj = 0; bj < 2; ++bj) { const int col = col0 + bj * HALF;
                    *(f32x4*)(orow + col) = acc[ai][bj][m][0] * sc * gv[bj][0]; *(f32x4*)(orow + col + 4) = acc[ai][bj][m][1] * sc * gv[bj][1]; } }
        __syncthreads();
    }
};

template <class Epi, class Sched>
DI void gemm_phase(LAS unsigned char* lds, const Gemm g, const Sched& S, const Epi& E, const int tid) {
    const int wid = __builtin_amdgcn_readfirstlane(tid >> 6), lane = tid & 63, wr = wid >> 2, wc = wid & 3, fr = lane & 15, fq = lane >> 4;
    const int K = g.K, nt = K / BK;
    unsigned voffA[2], voffB[2];
#pragma unroll
    for (int i = 0; i < 2; ++i) { int R, C; stage_rc(tid * 16 + i * 8192, R, C); const int Rb = Epi::PERM ? ((R & ~31) + perm32(R & 31)) : R;
        voffA[i] = (unsigned)(R * g.lda + C) * 2u; voffB[i] = (unsigned)(Rb * g.ldb + C) * 2u; }
    const size_t kstep = (size_t)(BK * 2);
    const size_t hstepA = (size_t)HALF * g.lda * 2, hstepB = (size_t)HALF * g.ldb * 2;
    const size_t tstepA = 2 * hstepA, tstepB = 2 * hstepB;
    const unsigned ldsw = (unsigned)wid * 1024u;
    const int aoff = lds_byte(wr * 64 + fr, fq * 8), boff = lds_byte(wc * 32 + fr, fq * 8);
#define PG8_SA(b, h) (((b) * 2 + (h)) * HTB)
#define PG8_SB(b, h) ((4 + (b) * 2 + (h)) * HTB)
#define PG8_STAGE(bufoff, gbase, voff) do { _Pragma("unroll") for (int _i = 0; _i < 2; ++_i) \
        __builtin_amdgcn_global_load_lds((const unsigned*)((const char*)(gbase) + (voff)[_i]), (LAS unsigned*)(lds + (bufoff) + ldsw + _i * 8192), 16, 0, 0); } while (0)
#define PG8_LDA(dst, b, h) do { _Pragma("unroll") for (int m = 0; m < 4; ++m) _Pragma("unroll") for (int k = 0; k < 2; ++k) dst[m][k] = *(const LAS bf16x8*)(lds + PG8_SA(b, h) + aoff + m * 2048 + k * 1024); } while (0)
#define PG8_LDB(dst, b, h) do { _Pragma("unroll") for (int n = 0; n < 2; ++n) _Pragma("unroll") for (int k = 0; k < 2; ++k) dst[n][k] = *(const LAS bf16x8*)(lds + PG8_SB(b, h) + boff + n * 2048 + k * 1024); } while (0)
#define PG8_MMA(ai, bj, At, Bt) do { __builtin_amdgcn_s_setprio(1); _Pragma("unroll") for (int m = 0; m < 4; ++m) _Pragma("unroll") for (int n = 0; n < 2; ++n) _Pragma("unroll") for (int k = 0; k < 2; ++k) \
        acc[ai][bj][m][n] = __builtin_amdgcn_mfma_f32_16x16x32_bf16(Bt[n][k], At[m][k], acc[ai][bj][m][n], 0, 0, 0); __builtin_amdgcn_s_setprio(0); } while (0)
#define PG8_WAIT_V(n) asm volatile("s_waitcnt vmcnt(" #n ")" ::: "memory")
#define PG8_WAIT_L(n) asm volatile("s_waitcnt lgkmcnt(" #n ")" ::: "memory")
#define PG8_BAR __builtin_amdgcn_s_barrier()
#define PG8_SCHED __builtin_amdgcn_sched_barrier(0)
#define PG8_APTR(u) ((const char*)g.A + (size_t)((u).z == 0 ? g.a0 : ((u).z == 1 ? g.a1 : g.a2)) * 2 + (size_t)(u).pm * tstepA)
#define PG8_BPTR(u) ((const char*)g.Bt + (size_t)(u).z * g.zB * 2 + (size_t)(u).pn * tstepB)
    Unit cur, nxt; int ui = 0;
    if (!S.next(0, cur)) return;
    f32x4 acc[2][2][4][2];
#pragma unroll
    for (int a = 0; a < 2; ++a)
#pragma unroll
        for (int b = 0; b < 2; ++b)
#pragma unroll
            for (int m = 0; m < 4; ++m)
#pragma unroll
                for (int n = 0; n < 2; ++n) acc[a][b][m][n] = (f32x4){0.f, 0.f, 0.f, 0.f};
    bf16x8 At[4][2], B0[2][2], B1[2][2];
    const char* cA = PG8_APTR(cur); const char* cB = PG8_BPTR(cur);
    PG8_STAGE(PG8_SB(0, 0), cB, voffB); PG8_STAGE(PG8_SB(0, 1), cB + hstepB, voffB); PG8_STAGE(PG8_SA(0, 0), cA, voffA); PG8_STAGE(PG8_SA(0, 1), cA + hstepA, voffA);
    if (wr == 1) PG8_BAR;
    PG8_WAIT_V(2); PG8_BAR;
    PG8_STAGE(PG8_SB(1, 0), cB + kstep, voffB); PG8_STAGE(PG8_SA(1, 0), cA + kstep, voffA); PG8_STAGE(PG8_SB(1, 1), cB + hstepB + kstep, voffB);
    PG8_WAIT_V(6); PG8_BAR;
    for (;;) {
        const bool has_next = S.next(ui + 1, nxt);
        const char* nA = has_next ? PG8_APTR(nxt) : cA; const char* nB = has_next ? PG8_BPTR(nxt) : cB;
        for (int t = 0; t < nt; t += 2) {
            const bool last = (t == nt - 2);
            const char* a1 = cA + (size_t)(t + 1) * kstep;
            const char* a2 = last ? nA : cA + (size_t)(t + 2) * kstep; const char* b2 = last ? nB : cB + (size_t)(t + 2) * kstep;
            const char* a3 = a2 + kstep; const char* b3 = b2 + kstep;
            PG8_LDB(B0, 0, 0); PG8_LDB(B1, 0, 1); PG8_SCHED; PG8_LDA(At, 0, 0); PG8_STAGE(PG8_SA(1, 1), a1 + hstepA, voffA);
            PG8_WAIT_V(8); PG8_WAIT_L(0); PG8_BAR; PG8_MMA(0, 0, At, B0); PG8_MMA(0, 1, At, B1); PG8_BAR; PG8_SCHED;
            PG8_LDA(At, 0, 1); PG8_STAGE(PG8_SB(0, 0), b2, voffB); PG8_STAGE(PG8_SB(0, 1), b2 + hstepB, voffB); PG8_STAGE(PG8_SA(0, 0), a2, voffA);
            PG8_WAIT_V(8); PG8_WAIT_L(0); PG8_BAR; PG8_MMA(1, 0, At, B0); PG8_MMA(1, 1, At, B1); PG8_BAR; PG8_SCHED;
            PG8_LDB(B0, 1, 0); PG8_LDB(B1, 1, 1); PG8_SCHED; PG8_LDA(At, 1, 0); PG8_STAGE(PG8_SA(0, 1), a2 + hstepA, voffA);
            PG8_WAIT_V(8); PG8_WAIT_L(0); PG8_BAR; PG8_MMA(0, 0, At, B0); PG8_MMA(0, 1, At, B1); PG8_BAR; PG8_SCHED;
            PG8_LDA(At, 1, 1); PG8_STAGE(PG8_SB(1, 0), b3, voffB); PG8_STAGE(PG8_SB(1, 1), b3 + hstepB, voffB); PG8_STAGE(PG8_SA(1, 0), a3, voffA);
            PG8_WAIT_V(8); PG8_WAIT_L(0); PG8_BAR; PG8_MMA(1, 0, At, B0); PG8_MMA(1, 1, At, B1); PG8_BAR; PG8_SCHED;
        }
        if (wr == 0) PG8_BAR;
        E(acc, cur, wr, wc, fr, fq);
        if (!has_next) break;
#pragma unroll
        for (int a = 0; a < 2; ++a)
#pragma unroll
            for (int b = 0; b < 2; ++b)
#pragma unroll
                for (int m = 0; m < 4; ++m)
#pragma unroll
                    for (int n = 0; n < 2; ++n) acc[a][b][m][n] = (f32x4){0.f, 0.f, 0.f, 0.f};
        cur = nxt; cA = nA; cB = nB; ++ui;
        if (wr == 1) PG8_BAR;
    }
    PG8_WAIT_V(0);
    PG8_BAR;
#undef PG8_SA
#undef PG8_SB
#undef PG8_STAGE
#undef PG8_LDA
#undef PG8_LDB
#undef PG8_MMA
#undef PG8_WAIT_V
#undef PG8_WAIT_L
#undef PG8_BAR
#undef PG8_SCHED
#undef PG8_APTR
#undef PG8_BPTR
}
}

#define MFMA32(a, b, c) __builtin_amdgcn_mfma_f32_32x32x16_bf16((a), (b), (c), 0, 0, 0)
DI s16x4 vtr(LAS unsigned char* p) { return __builtin_bit_cast(s16x4, __builtin_amdgcn_ds_read_tr16_b64_v4i16((LAS v4i16_t*)p)); }

template <int D, class MaskT>
DI void tile_compute(const LAS unsigned char* krd, LAS unsigned char* vrd, const bf16x8 (&qf)[D / 16], const MaskT& maskt, f32x16 (&o)[D / 32], float& m, float& l) {
    constexpr int NKS = D / 16, NDB = D / 32;
    typedef float f32x8_t __attribute__((ext_vector_type(8)));
    f32x16 s;
#pragma unroll
    for (int i = 0; i < 16; ++i) s[i] = 0.f;
#pragma unroll
    for (int ks = 0; ks < NKS; ++ks) { const bf16x8 kf = *(const LAS bf16x8*)(krd + ks * 32); s = MFMA32(kf, qf[ks], s); }
    maskt(s);
    float mx = fmaxf(fmaxf(s[0], s[1]), s[2]);
    mx = fmaxf(fmaxf(mx, s[3]), s[4]); mx = fmaxf(fmaxf(mx, s[5]), s[6]); mx = fmaxf(fmaxf(mx, s[7]), s[8]); mx = fmaxf(fmaxf(mx, s[9]), s[10]);
    mx = fmaxf(fmaxf(mx, s[11]), s[12]); mx = fmaxf(fmaxf(mx, s[13]), s[14]); mx = fmaxf(mx, s[15]);
    mx = fmaxf(mx, __shfl_xor(mx, 32));
    const float mn = fmaxf(m, mx);
    if (__builtin_amdgcn_ballot_w64(mn > m) != 0ull) {
        const float alpha = fexp2(m - mn); l *= alpha;
#pragma unroll
        for (int d = 0; d < NDB; ++d) o[d] = o[d] * alpha;
    }
    m = mn;
    s = s - mn;
#pragma unroll
    for (int i = 0; i < 16; ++i) s[i] = fexp2(s[i]);
    { const f32x8_t a8 = s.lo + s.hi; const f32x4 a4 = a8.lo + a8.hi; l += (a4[0] + a4[1]) + (a4[2] + a4[3]); }
    u32x4 p0, p1;
    p0.x = pk2(s[0], s[1]); p0.y = pk2(s[2], s[3]); p0.z = pk2(s[4], s[5]); p0.w = pk2(s[6], s[7]);
    p1.x = pk2(s[8], s[9]); p1.y = pk2(s[10], s[11]); p1.z = pk2(s[12], s[13]); p1.w = pk2(s[14], s[15]);
    const bf16x8 pb0 = __builtin_bit_cast(bf16x8, p0), pb1 = __builtin_bit_cast(bf16x8, p1);
#pragma unroll
    for (int d = 0; d < NDB; ++d) {
        const s16x4 a0 = vtr(vrd + d * 2048), a1 = vtr(vrd + d * 2048 + 8 * 64);
        const s16x4 b0 = vtr(vrd + d * 2048 + 16 * 64), b1 = vtr(vrd + d * 2048 + 24 * 64);
        const bf16x8 va0 = __builtin_shufflevector(a0, a1, 0, 1, 2, 3, 4, 5, 6, 7), va1 = __builtin_shufflevector(b0, b1, 0, 1, 2, 3, 4, 5, 6, 7);
        o[d] = MFMA32(va0, pb0, o[d]);
        o[d] = MFMA32(va1, pb1, o[d]);
    }
}

template <int D, class KTok, class MaskF>
DI void attn_run(const bf16_t* qp, const bf16_t* kbase, const bf16_t* vbase, size_t pitch, int ntiles, const KTok& ktok, const MaskF& maskf,
                 LAS unsigned char* vimg, f32x16 (&o)[D / 32], float& m_out, float& l_out, const int lane) {
    const int r = lane & 31, hi = lane >> 5;
    constexpr int NKS = D / 16, NDB = D / 32, CPR = D / 8, RPI = 64 / CPR, NI = 32 / RPI, KSTR = D * 2 + 16;
    LAS unsigned char* kimg = vimg + D * 64;
    bf16x8 qf[NKS];
#pragma unroll
    for (int ks = 0; ks < NKS; ++ks) qf[ks] = *(const bf16x8*)(qp + 16 * ks + 8 * hi);
#pragma unroll
    for (int d = 0; d < NDB; ++d)
#pragma unroll
        for (int i = 0; i < 16; ++i) o[d][i] = 0.f;
    float m = -1e30f, l = 0.f;
    const int vkey = lane / CPR, vc = lane % CPR;
    LAS unsigned char* vwr = vimg + (vc >> 2) * 2048 + vkey * 64 + (vc & 3) * 16;
    LAS unsigned char* kwr = kimg + vkey * KSTR + vc * 16;
    const LAS unsigned char* krd = kimg + r * KSTR + hi * 16;
    const int dgrp = (lane >> 4) & 1, tq = (lane & 15) >> 2, tp = lane & 3;
    LAS unsigned char* vrd = vimg + (4 * hi + tq) * 64 + (16 * dgrp + 4 * tp) * 2;
    u32x4 kk[3][NI], vv[3][NI];
#define AR_LOAD(J, T) do { const int _t = ((T) < ntiles) ? (T) : (ntiles - 1); _Pragma("unroll") for (int i = 0; i < NI; ++i) { \
        const size_t ro = (size_t)ktok(_t, i * RPI + vkey) * pitch + 8 * vc; kk[J][i] = *(const u32x4*)(kbase + ro); vv[J][i] = *(const u32x4*)(vbase + ro); } } while (0)
#define AR_STEP(J, T) do { _Pragma("unroll") for (int i = 0; i < NI; ++i) { *(LAS u32x4*)(kwr + i * RPI * KSTR) = kk[J][i]; *(LAS u32x4*)(vwr + i * RPI * 64) = vv[J][i]; } \
        asm volatile("" ::: "memory"); AR_LOAD(J, (T) + 3); \
        { const int _tt = (T); tile_compute<D>(krd, vrd, qf, [&](f32x16& s) { maskf(_tt, s); }, o, m, l); } asm volatile("" ::: "memory"); } while (0)
    AR_LOAD(0, 0); AR_LOAD(1, 1); AR_LOAD(2, 2);
    for (int t = 0; t < ntiles; t += 3) {
        AR_STEP(0, t);
        if (t + 1 < ntiles) AR_STEP(1, t + 1);
        if (t + 2 < ntiles) AR_STEP(2, t + 2);
    }
#undef AR_LOAD
#undef AR_STEP
    m_out = m; l_out = l + __shfl_xor(l, 32);
}

struct Ctx {
    const float* in[14]; float* out; unsigned char* ws;
    bf16_t *win_t, *wkv_t, *wp_t, *wout_t, *hn, *memh, *memkv, *proj, *merged; float *ssq, *lse;
    int ch, G, tid, bid;
};

DI void unit_M(const Ctx& X, int chunk, int u, LAS unsigned char* vimg, int dry) {
    const int lane = X.tid & 63, r = lane & 31, hi = lane >> 5;
    const int seq = u >> 8, rem = u & 255, h = rem >> 6, tile = rem & 63;
    const int tok = seq * SEQ + tile * 32 + r;
    bf16_t* prow = X.proj + (size_t)tok * LDP;
    const int gseq = chunk * X.ch + seq;
    const bf16_t* kb = X.memkv + (size_t)gseq * NMEM * DM + h * 128;
    f32x16 o[4]; float m, l;
    const float c1 = 0.08838834764831845f * LOG2E;
    attn_run<128>(prow + C_MQ + h * 128, kb, kb + 512, (size_t)DM, 8,
                  [](int t, int kk) { return t * 32 + kk; },
                  [c1](int, f32x16& s) {
#pragma unroll
                      for (int i = 0; i < 16; ++i) s[i] *= c1; },
                  vimg, o, m, l, lane);
    const float inv = frcp(l);
#pragma unroll
    for (int d = 0; d < 4; ++d)
#pragma unroll
        for (int gq = 0; gq < 4; ++gq) {
            const int d0 = 32 * d + 8 * gq + 4 * hi;
            const u32x2 gt = *(const u32x2*)(prow + C_MG + h * 128 + d0);
            u32x2 w; w.x = pk2(o[d][4 * gq] * inv * siluf_(bf_lo(gt.x)), o[d][4 * gq + 1] * inv * siluf_(bf_hi(gt.x)));
            w.y = pk2(o[d][4 * gq + 2] * inv * siluf_(bf_lo(gt.y)), o[d][4 * gq + 3] * inv * siluf_(bf_hi(gt.y)));
            *(u32x2*)(dry ? X.merged + (size_t)tok * DM + h * 128 + d0 : prow + C_MQ + h * 128 + d0) = w;
        }
}

DI void unit_B(const Ctx& X, int u, LAS unsigned char* vimg, const LAS float* rpb_lds, int dry) {
    const int lane = X.tid & 63, r = lane & 31, hi = lane >> 5;
    const int seq = u >> 9, rem = u & 511, h = rem >> 6, pt = rem & 63, rp = pt >> 2, cb = pt & 3;
    const int qr = 2 * rp + (r >> 4), qc = 16 * cb + (r & 15);
    const int tok = seq * SEQ + qr * 64 + qc;
    bf16_t* prow = X.proj + (size_t)tok * LDP;
    const int ra = 2 * rp - 4, rb = 2 * rp + 1 - 4;
    const int krlo = ra < 0 ? 0 : (ra > 24 ? 24 : ra), krhi = (rb < 0 ? 0 : (rb > 24 ? 24 : rb)) + 7;
    const int sc0 = 16 * cb - 8; const int kstart0 = sc0 < 0 ? 0 : (sc0 > 48 ? 48 : sc0); const int kstart = kstart0 > 32 ? 32 : kstart0;
    const int r0q = (qr - 4) < 0 ? 0 : ((qr - 4) > 24 ? 24 : (qr - 4));
    const int scq = (qc - 8) < 0 ? 0 : ((qc - 8) > 48 ? 48 : (qc - 8));
    const int lo = scq - kstart;
    const float fl = (float)(4 * hi - lo) - 7.5f;
    const int dcb = kstart - qc + 15 + 16 + 4 * hi;
    const LAS float* rp_h = rpb_lds + h * (15 * 64);
    const bf16_t* kb = X.proj + (size_t)seq * SEQ * LDP + C_BK + h * 64;
    const float c1 = 0.125f * LOG2E;
    f32x16 o[2]; float m, l;
#if PROBE == 8
    const size_t bpitch = dry ? (size_t)64 : (size_t)LDP;
#else
    const size_t bpitch = LDP;
#endif
#if PROBE == 9
    const int bnt = dry ? 1 : (krhi - krlo + 1);
#else
    const int bnt = krhi - krlo + 1;
#endif
    attn_run<64>(prow + C_BQ + h * 64, kb, kb + (C_BV - C_BK), bpitch, bnt,
                 [krlo, kstart](int t, int kk) { return (krlo + t) * 64 + kstart + kk; },
                 [=](int t, f32x16& s) {
                     const int kr = krlo + t; const bool rowok = (kr >= r0q) && (kr <= r0q + 7);
                     int dr = kr - qr + 7; dr = dr < 0 ? 0 : (dr > 14 ? 14 : dr);
                     const volatile LAS float* bp = rp_h + dr * 64 + dcb;
                     const float flt = rowok ? fl : 1e9f;
#define BEL(i, CF) { const float b = bp[CF]; const float tt = (float)(CF) + flt; s[i] = (fabsf(tt) <= 7.5f) ? fmaf(s[i], c1, b) : -1e30f; }
                     BEL(0, 0) BEL(1, 1) BEL(2, 2) BEL(3, 3) BEL(4, 8) BEL(5, 9) BEL(6, 10) BEL(7, 11) BEL(8, 16) BEL(9, 17) BEL(10, 18) BEL(11, 19) BEL(12, 24) BEL(13, 25) BEL(14, 26) BEL(15, 27)
#undef BEL
                 },
                 vimg, o, m, l, lane);
    const float inv = frcp(l);
#pragma unroll
    for (int d = 0; d < 2; ++d)
#pragma unroll
        for (int gq = 0; gq < 4; ++gq) {
            const int d0 = 32 * d + 8 * gq + 4 * hi;
            const u32x2 gt = *(const u32x2*)(prow + C_BG + h * 64 + d0);
            u32x2 w; w.x = pk2(o[d][4 * gq] * inv * siluf_(bf_lo(gt.x)), o[d][4 * gq + 1] * inv * siluf_(bf_hi(gt.x)));
            w.y = pk2(o[d][4 * gq + 2] * inv * siluf_(bf_lo(gt.y)), o[d][4 * gq + 3] * inv * siluf_(bf_hi(gt.y)));
            *(u32x2*)(dry ? X.merged + (size_t)tok * DM + 512 + h * 64 + d0 : prow + C_BQ + h * 64 + d0) = w;
        }
}

DI void unit_A(const Ctx& X, int u, LAS unsigned char* vimg, int dry) {
    const int lane = X.tid & 63, r = lane & 31, hi = lane >> 5;
    const int seq = u / 1536, rem = u - seq * 1536, g = rem >> 9, rem2 = rem & 511, h = rem2 >> 6, tt = rem2 & 63;
    const int sh = 2 * g, tpr = 64 >> sh, res = tt / tpr, tl = tt - res * tpr;
    const int tok = seq * SEQ + (((32 * tl + r) << sh) + res);
    bf16_t* prow = X.proj + (size_t)tok * LDP;
    const int jt0 = (tl - 2) < 0 ? 0 : (tl - 2), jt1 = (tl + 2) > (tpr - 1) ? (tpr - 1) : (tl + 2);
    const float slope = fexp2(-(float)(g * 8 + h + 1) * (1.0f / 3.0f));
    const float c1 = 0.125f * LOG2E, c2 = slope * (float)(1 << sh) * LOG2E;
    const bf16_t* kb = X.proj + ((size_t)seq * SEQ + res) * LDP + C_AK + g * 512 + h * 64;
    f32x16 o[2]; float m, l;
    attn_run<64>(prow + C_AQ + g * 512 + h * 64, kb, kb + (C_AV - C_AK), (size_t)LDP, jt1 - jt0 + 1,
                 [jt0, sh](int t, int kk) { return (32 * (jt0 + t) + kk) << sh; },
                 [=](int t, f32x16& s) {
                     const int base = 32 * (jt0 + t - tl) - r;
#pragma unroll
                     for (int i = 0; i < 16; ++i) { const int off = base + crow(i, hi); const int ao = off < 0 ? -off : off;
                         s[i] = (ao <= 64) ? (s[i] * c1 - c2 * (float)ao) : -1e30f; } },
                 vimg, o, m, l, lane);
    const float inv = frcp(l);
#pragma unroll
    for (int d = 0; d < 2; ++d)
#pragma unroll
        for (int gq = 0; gq < 4; ++gq) {
            const int d0 = 32 * d + 8 * gq + 4 * hi;
            u32x2 w; w.x = pk2(o[d][4 * gq] * inv, o[d][4 * gq + 1] * inv); w.y = pk2(o[d][4 * gq + 2] * inv, o[d][4 * gq + 3] * inv);
            *(u32x2*)(dry ? X.merged + (size_t)tok * DM + ((g * 512 + h * 64 + d0) & 1023) : prow + C_AQ + g * 512 + h * 64 + d0) = w;
        }
    if (hi == 0) X.lse[(size_t)tok * 24 + g * 8 + h] = m + __builtin_amdgcn_logf(l);
}

DI void rms_rows(const float* __restrict__ src, const float* __restrict__ gain, bf16_t* dst, int nrows, int gw, int nw, int tid) {
    const int lane = tid & 63;
    f32x4 gv[4];
#pragma unroll
    for (int i = 0; i < 4; ++i) gv[i] = *(const f32x4*)(gain + i * 256 + lane * 4);
    for (int row = gw; row < nrows; row += nw) {
        const float* p = src + (size_t)row * DM; f32x4 v[4]; float ss = 0.f;
#pragma unroll
        for (int i = 0; i < 4; ++i) { v[i] = *(const f32x4*)(p + i * 256 + lane * 4); ss += (v[i][0] * v[i][0] + v[i][1] * v[i][1]) + (v[i][2] * v[i][2] + v[i][3] * v[i][3]); }
        ss = wave_sum(ss);
        const float sc = __builtin_amdgcn_rsqf(ss * (1.0f / DM) + RMS_EPS);
#pragma unroll
        for (int i = 0; i < 4; ++i) { u32x2 w; w.x = pk2(v[i][0] * sc * gv[i][0], v[i][1] * sc * gv[i][1]); w.y = pk2(v[i][2] * sc * gv[i][2], v[i][3] * sc * gv[i][3]);
            *(u32x2*)(dst + (size_t)row * DM + i * 256 + lane * 4) = w; }
    }
}

DI void rms_tokens(const float* __restrict__ xp, const float* __restrict__ xs, const float* __restrict__ gain, bf16_t* dst, int tok0, int nrows, int gw, int nw, int tid, int split = NPROMPT_TOK) {
    const int lane = tid & 63;
    f32x4 gv[4];
#pragma unroll
    for (int i = 0; i < 4; ++i) gv[i] = *(const f32x4*)(gain + i * 256 + lane * 4);
    for (int row0 = gw; row0 < nrows; row0 += 4 * nw) {
        f32x4 v[4][4];
#pragma unroll
        for (int u = 0; u < 4; ++u) { const int row = (row0 + u * nw < nrows) ? row0 + u * nw : row0; const int tg = tok0 + row;
            const float* p = (tg < split) ? xp + (size_t)tg * DM : xs + (size_t)(tg - split) * DM;
#pragma unroll
            for (int i = 0; i < 4; ++i) v[u][i] = *(const f32x4*)(p + i * 256 + lane * 4); }
#pragma unroll
        for (int u = 0; u < 4; ++u) { const int row = row0 + u * nw; float ss = 0.f;
#pragma unroll
            for (int i = 0; i < 4; ++i) ss += (v[u][i][0] * v[u][i][0] + v[u][i][1] * v[u][i][1]) + (v[u][i][2] * v[u][i][2] + v[u][i][3] * v[u][i][3]);
            ss = wave_sum(ss);
            const float sc = __builtin_amdgcn_rsqf(ss * (1.0f / DM) + RMS_EPS);
            if (row < nrows) {
#pragma unroll
                for (int i = 0; i < 4; ++i) { u32x2 w; w.x = pk2(v[u][i][0] * sc * gv[i][0], v[u][i][1] * sc * gv[i][1]); w.y = pk2(v[u][i][2] * sc * gv[i][2], v[u][i][3] * sc * gv[i][3]);
                    *(u32x2*)(dst + (size_t)row * DM + i * 256 + lane * 4) = w; } } }
    }
}

DI void transpose_tiles(const float* __restrict__ W, int K, int N, bf16_t* WT, LAS float* tile, int bid, int nb, int tid) {
    const int tn = N / 64, ntile = (K / 64) * tn;
    for (int t = bid; t < ntile; t += nb) {
        const int k0 = (t / tn) * 64, n0 = (t % tn) * 64;
#pragma unroll
        for (int i = 0; i < 2; ++i) { const int kk = (tid >> 4) + 32 * i, n4 = (tid & 15) * 4;
            const f32x4 v = *(const f32x4*)(W + (size_t)(k0 + kk) * N + n0 + n4);
            tile[kk * 65 + n4] = v[0]; tile[kk * 65 + n4 + 1] = v[1]; tile[kk * 65 + n4 + 2] = v[2]; tile[kk * 65 + n4 + 3] = v[3]; }
        __syncthreads();
        { const int n = tid >> 3, kc = (tid & 7) * 8;
          u32x4 w; w.x = pk2(tile[(kc + 0) * 65 + n], tile[(kc + 1) * 65 + n]); w.y = pk2(tile[(kc + 2) * 65 + n], tile[(kc + 3) * 65 + n]);
          w.z = pk2(tile[(kc + 4) * 65 + n], tile[(kc + 5) * 65 + n]); w.w = pk2(tile[(kc + 6) * 65 + n], tile[(kc + 7) * 65 + n]);
          *(u32x4*)(WT + (size_t)(n0 + n) * K + k0 + kc) = w; }
        __syncthreads();
    }
}

DI void phase_p0(const Ctx& X, LAS unsigned char* lds) {
    const int tid = X.tid; const int wave = __builtin_amdgcn_readfirstlane(tid >> 6);
    const int gw = X.bid * 8 + wave, nw = X.G * 8, bid = X.bid, nb = X.G;
    LAS float* tile = (LAS float*)lds;
    transpose_tiles(X.in[6], DM, DIN, X.win_t, tile, bid, nb, tid);
    transpose_tiles(X.in[7], DM, DM, X.wkv_t, tile, (bid + 64) % nb, nb, tid);
    transpose_tiles(X.in[9], 512, DM, X.wp_t, tile, (bid + 128) % nb, nb, tid);
    transpose_tiles(X.in[10], 512, DM, X.wp_t + 1024 * 512, tile, (bid + 160) % nb, nb, tid);
    transpose_tiles(X.in[11], 512, DM, X.wp_t + 2 * 1024 * 512, tile, (bid + 192) % nb, nb, tid);
    transpose_tiles(X.in[12], DM, DM, X.wout_t, tile, (bid + 224) % nb, nb, tid);
    rms_tokens(X.in[0], X.in[1], X.in[4], X.hn, 0, X.ch * SEQ, gw, nw, tid);
    rms_tokens(X.in[2], X.in[3], X.in[5], X.memh, 0, NSEQ * NMEM, gw, nw, tid, 32 * NMEM);
}

constexpr int A_SLOT = 8704;
struct AUnit { int seq, g, h, blk; };
DI AUnit a_decode(int ub) { AUnit a; a.seq = ub / 192; const int rem = ub - a.seq * 192; a.g = rem >> 6; a.h = (rem & 63) >> 3; a.blk = rem & 7; return a; }
DI void a_issue(const Ctx& X, const AUnit& a, int wave, int lkv, int lkey, int lc, int r, int hi, u32x4 (&L)[12], bf16x8 (&qn)[4]) {
    const int sh = 2 * a.g, T = 64 >> sh;
    const bf16_t* base = X.proj + (size_t)a.seq * SEQ * LDP + (lkv ? C_AV : C_AK) + a.g * 512 + a.h * 64 + 8 * lc;
    const int res01 = (a.g == 0) ? 0 : (a.blk >> 1), qt0 = (a.g == 0) ? 8 * a.blk : 8 * (a.blk & 1);
#pragma unroll
    for (int j = 0; j < 12; ++j) {
        int res_j, kt_j; bool valid;
        if (a.g < 2) { res_j = res01; kt_j = qt0 - 2 + j; valid = (kt_j >= 0) && (kt_j < T); }
        else { res_j = 2 * a.blk + (j >> 2); kt_j = j & 3; valid = (j < 8); }
        if (valid) L[j] = *(const u32x4*)(base + (size_t)(((32 * kt_j + lkey) << sh) + res_j) * LDP);
        else L[j] = (u32x4){0u, 0u, 0u, 0u};
    }
    const int res_w = (a.g < 2) ? res01 : 2 * a.blk + (wave >> 2), qt_w = (a.g < 2) ? qt0 + wave : (wave & 3);
    const bf16_t* qp = X.proj + ((size_t)a.seq * SEQ + (((32 * qt_w + r) << sh) + res_w)) * LDP + C_AQ + a.g * 512 + a.h * 64;
#pragma unroll
    for (int ks = 0; ks < 4; ++ks) qn[ks] = *(const bf16x8*)(qp + 16 * ks + 8 * hi);
}
DI void a_block_phase(const Ctx& X, LAS unsigned char* lds) {
    const int tid = X.tid, lane = tid & 63, wave = __builtin_amdgcn_readfirstlane(tid >> 6), r = lane & 31, hi = lane >> 5;
    LAS unsigned char* slots = lds + 16384;
    const int nunits = X.ch * 192;
    const int lkv = tid >> 8, lkey = (tid >> 3) & 31, lc = tid & 7;
    const int lwoff = lkv ? ((lc >> 2) * 2048 + lkey * 64 + (lc & 3) * 16) : (4096 + lkey * 144 + lc * 16);
    const int dgrp = (lane >> 4) & 1, tq = (lane & 15) >> 2, tp = lane & 3;
    const int vrd_off = (4 * hi + tq) * 64 + (16 * dgrp + 4 * tp) * 2, krd_off = 4096 + r * 144 + hi * 16;
    u32x4 L[12]; bf16x8 qn[4];
    int ub = X.bid;
    if (ub < nunits) { const AUnit a = a_decode(ub); a_issue(X, a, wave, lkv, lkey, lc, r, hi, L, qn); }
    while (ub < nunits) {
        const AUnit a = a_decode(ub);
        __syncthreads();
#pragma unroll
        for (int j = 0; j < 12; ++j) *(LAS u32x4*)(slots + j * A_SLOT + lwoff) = L[j];
        bf16x8 qf[4];
#pragma unroll
        for (int ks = 0; ks < 4; ++ks) qf[ks] = qn[ks];
        __syncthreads();
        const int ubn = ub + X.G;
        if (ubn < nunits) { const AUnit an = a_decode(ubn); a_issue(X, an, wave, lkv, lkey, lc, r, hi, L, qn); }
        const int sh = 2 * a.g, T = 64 >> sh;
        const int res01 = (a.g == 0) ? 0 : (a.blk >> 1), qt0 = (a.g == 0) ? 8 * a.blk : 8 * (a.blk & 1);
        const int res_w = (a.g < 2) ? res01 : 2 * a.blk + (wave >> 2), qt_w = (a.g < 2) ? qt0 + wave : (wave & 3);
        const int ktbase = (a.g < 2) ? qt0 - 2 : -4 * (wave >> 2);
        const int kt0 = (qt_w - 2) < 0 ? 0 : (qt_w - 2), kt1 = (qt_w + 2) > (T - 1) ? (T - 1) : (qt_w + 2);
        const float slope = fexp2(-(float)(a.g * 8 + a.h + 1) * (1.0f / 3.0f));
        const float c1 = 0.125f * LOG2E, c2 = slope * (float)(1 << sh) * LOG2E;
        f32x16 o[2]; float m = -1e30f, l = 0.f;
#pragma unroll
        for (int d = 0; d < 2; ++d)
#pragma unroll
            for (int i = 0; i < 16; ++i) o[d][i] = 0.f;
        const float dl = (float)(4 * hi - r);
        const f32x16 cfv = {0.f, 1.f, 2.f, 3.f, 8.f, 9.f, 10.f, 11.f, 16.f, 17.f, 18.f, 19.f, 24.f, 25.f, 26.f, 27.f};
        for (int kt = kt0; kt <= kt1; ++kt) {
            LAS unsigned char* sl = slots + (kt - ktbase) * A_SLOT;
            const int dlt = kt - qt_w;
            if (dlt == 0) {
                tile_compute<64>(sl + krd_off, sl + vrd_off, qf, [=](f32x16& s) {
                    const f32x16 dv = cfv + dl;
#pragma unroll
                    for (int i = 0; i < 16; ++i) s[i] = fmaf(s[i], c1, -c2 * fabsf(dv[i])); }, o, m, l);
            } else {
                const float B = (dlt > 0) ? -c2 : c2, A = -c2 * 32.f * (float)(dlt > 0 ? dlt : -dlt) + B * dl;
                const bool edge = (dlt == 2) || (dlt == -2);
                const float thr = edge ? -c2 * 64.5f : -3e38f;
                tile_compute<64>(sl + krd_off, sl + vrd_off, qf, [=](f32x16& s) {
                    const f32x16 bias = cfv * B + A;
                    s = s * c1 + bias;
                    if (edge) {
#pragma unroll
                        for (int i = 0; i < 16; ++i) s[i] = (bias[i] >= thr) ? s[i] : -1e30f; } }, o, m, l);
            }
        }
        l += __shfl_xor(l, 32);
        const float inv = frcp(l);
        const int tok = a.seq * SEQ + (((32 * qt_w + r) << sh) + res_w);
        bf16_t* prow = X.proj + (size_t)tok * LDP + C_AQ + a.g * 512 + a.h * 64;
#pragma unroll
        for (int d = 0; d < 2; ++d)
#pragma unroll
            for (int gq = 0; gq < 4; ++gq) {
                const int d0 = 32 * d + 8 * gq + 4 * hi;
                u32x2 w; w.x = pk2(o[d][4 * gq] * inv, o[d][4 * gq + 1] * inv); w.y = pk2(o[d][4 * gq + 2] * inv, o[d][4 * gq + 3] * inv);
                *(u32x2*)(prow + d0) = w;
            }
        if (hi == 0) X.lse[(size_t)tok * 24 + a.g * 8 + a.h] = m + __builtin_amdgcn_logf(l);
        ub = ubn;
    }
    __syncthreads();
}

constexpr int M_SLOT = 16896;
DI void m_block_phase(const Ctx& X, int chunk, LAS unsigned char* lds) {
    const int tid = X.tid, lane = tid & 63, wave = __builtin_amdgcn_readfirstlane(tid >> 6), r = lane & 31, hi = lane >> 5;
    LAS unsigned char* slots = lds + 16384;
    const int nunits = X.ch * 16;
    const int lkey = tid >> 4, lc = tid & 15;
    const int kwoff = 8192 + lkey * 272 + lc * 16, vwoff = (lc >> 2) * 2048 + lkey * 64 + (lc & 3) * 16;
    const int dgrp = (lane >> 4) & 1, tq = (lane & 15) >> 2, tp = lane & 3;
    const int vrd_off = (4 * hi + tq) * 64 + (16 * dgrp + 4 * tp) * 2, krd_off = 8192 + r * 272 + hi * 16;
    const float c1 = 0.08838834764831845f * LOG2E;
    for (int um = X.bid; um < nunits; um += X.G) {
        const int seq = um >> 4, h = (um >> 2) & 3, pair = um & 3;
        const int gseq = chunk * X.ch + seq;
        const bf16_t* kb = X.memkv + (size_t)gseq * NMEM * DM + h * 128 + 8 * lc;
        __syncthreads();
        {
            u32x4 LK[8], LV[8];
#pragma unroll
            for (int j = 0; j < 8; ++j) { const bf16_t* p = kb + (size_t)(32 * j + lkey) * DM; LK[j] = *(const u32x4*)p; LV[j] = *(const u32x4*)(p + 512); }
#pragma unroll
            for (int j = 0; j < 8; ++j) { *(LAS u32x4*)(slots + j * M_SLOT + kwoff) = LK[j]; *(LAS u32x4*)(slots + j * M_SLOT + vwoff) = LV[j]; }
        }
        __syncthreads();
        for (int rep = 0; rep < 2; ++rep) {
            const int tok = seq * SEQ + ((2 * pair + rep) * 8 + wave) * 32 + r;
            bf16_t* prow = X.proj + (size_t)tok * LDP;
            bf16x8 qf[8];
#pragma unroll
            for (int ks = 0; ks < 8; ++ks) qf[ks] = *(const bf16x8*)(prow + C_MQ + h * 128 + 16 * ks + 8 * hi);
            f32x16 o[4]; float m = -1e30f, l = 0.f;
#pragma unroll
            for (int d = 0; d < 4; ++d)
#pragma unroll
                for (int i = 0; i < 16; ++i) o[d][i] = 0.f;
            for (int t = 0; t < 8; ++t) {
                LAS unsigned char* sl = slots + t * M_SLOT;
                tile_compute<128>(sl + krd_off, sl + vrd_off, qf, [c1](f32x16& s) {
#pragma unroll
                    for (int i = 0; i < 16; ++i) s[i] *= c1; }, o, m, l);
            }
            l += __shfl_xor(l, 32);
            const float inv = frcp(l);
#pragma unroll
            for (int d = 0; d < 4; ++d)
#pragma unroll
                for (int gq = 0; gq < 4; ++gq) {
                    const int d0 = 32 * d + 8 * gq + 4 * hi;
                    const u32x2 gt = *(const u32x2*)(prow + C_MG + h * 128 + d0);
                    u32x2 w; w.x = pk2(o[d][4 * gq] * inv * siluf_(bf_lo(gt.x)), o[d][4 * gq + 1] * inv * siluf_(bf_hi(gt.x)));
                    w.y = pk2(o[d][4 * gq + 2] * inv * siluf_(bf_lo(gt.y)), o[d][4 * gq + 3] * inv * siluf_(bf_hi(gt.y)));
                    *(u32x2*)(prow + C_MQ + h * 128 + d0) = w;
                }
        }
    }
    __syncthreads();
}

struct BUnit { int seq, h, rp, cb, krlo, nt, kstart; };
DI BUnit b_decode(int u) {
    BUnit b; b.seq = u >> 9; const int rem = u & 511; b.h = rem >> 6; const int pt = rem & 63; b.rp = pt >> 2; b.cb = pt & 3;
    const int ra = 2 * b.rp - 4, rb = 2 * b.rp - 3;
    b.krlo = ra < 0 ? 0 : (ra > 24 ? 24 : ra); const int krhi = (rb < 0 ? 0 : (rb > 24 ? 24 : rb)) + 7; b.nt = krhi - b.krlo + 1;
    const int sc0 = 16 * b.cb - 8; const int k0 = sc0 < 0 ? 0 : (sc0 > 48 ? 48 : sc0); b.kstart = k0 > 32 ? 32 : k0;
    return b;
}
DI void b_stream_phase(const Ctx& X, LAS unsigned char* vimg, const LAS float* rpb_lds, int gw, int nw, int nB) {
    const int lane = X.tid & 63, r = lane & 31, hi = lane >> 5;
    constexpr int KSTR = 144;
    LAS unsigned char* kimg = vimg + 4096;
    const int vkey = lane >> 3, vc = lane & 7;
    LAS unsigned char* vwr = vimg + (vc >> 2) * 2048 + vkey * 64 + (vc & 3) * 16;
    LAS unsigned char* kwr = kimg + vkey * KSTR + vc * 16;
    const LAS unsigned char* krd = kimg + r * KSTR + hi * 16;
    const int dgrp = (lane >> 4) & 1, tq = (lane & 15) >> 2, tp = lane & 3;
    LAS unsigned char* vrd = vimg + (4 * hi + tq) * 64 + (16 * dgrp + 4 * tp) * 2;
    const float c1 = 0.125f * LOG2E;
    int u = gw; if (u >= nB) return;
    BUnit cu = b_decode(u);
    int pu = u, ptile = 0; BUnit pb = cu;
    u32x4 kk[2][4], vv[2][4];
#define B_PF(J) do { if (pu < nB) { const bf16_t* _kb = X.proj + ((size_t)pb.seq * SEQ + (pb.krlo + ptile) * 64 + pb.kstart + vkey) * LDP + C_BK + pb.h * 64 + 8 * vc; \
        _Pragma("unroll") for (int i = 0; i < 4; ++i) { kk[J][i] = *(const u32x4*)(_kb + (size_t)(8 * i) * LDP); vv[J][i] = *(const u32x4*)(_kb + (size_t)(8 * i) * LDP + (C_BV - C_BK)); } \
        if (++ptile == pb.nt) { pu += nw; ptile = 0; if (pu < nB) pb = b_decode(pu); } } } while (0)
    B_PF(0); B_PF(1);
    bf16x8 qf[4], qn[4]; u32x2 gg[8];
    int qr, qc, dcb; float fl;
#define B_LANE(b) do { qr = 2 * (b).rp + (r >> 4); qc = 16 * (b).cb + (r & 15); \
        const int _scq = (qc - 8) < 0 ? 0 : ((qc - 8) > 48 ? 48 : (qc - 8)); fl = (float)(4 * hi - (_scq - (b).kstart)) - 7.5f; dcb = (b).kstart - qc + 31 + 4 * hi; } while (0)
#define B_PROW(b) (X.proj + ((size_t)(b).seq * SEQ + qr * 64 + qc) * LDP)
#define B_Q(b, Q) do { const int _qr = 2 * (b).rp + (r >> 4), _qc = 16 * (b).cb + (r & 15); const bf16_t* _p = X.proj + ((size_t)(b).seq * SEQ + _qr * 64 + _qc) * LDP; \
        _Pragma("unroll") for (int ks = 0; ks < 4; ++ks) Q[ks] = *(const bf16x8*)(_p + C_BQ + (b).h * 64 + 16 * ks + 8 * hi); } while (0)
#define B_G(b) do { _Pragma("unroll") for (int d = 0; d < 2; ++d) _Pragma("unroll") for (int gq = 0; gq < 4; ++gq) gg[d * 4 + gq] = *(const u32x2*)(B_PROW(b) + C_BG + (b).h * 64 + 32 * d + 8 * gq + 4 * hi); } while (0)
    B_LANE(cu); B_Q(cu, qf); B_G(cu);
    { const int nu = u + nw; if (nu < nB) { const BUnit nb = b_decode(nu); B_Q(nb, qn); } }
    f32x16 o[2]; float m = -1e30f, l = 0.f; int t = 0;
#pragma unroll
    for (int d = 0; d < 2; ++d)
#pragma unroll
        for (int i = 0; i < 16; ++i) o[d][i] = 0.f;
    bool done = false;
#define B_STEP(J) do { \
        _Pragma("unroll") for (int i = 0; i < 4; ++i) { *(LAS u32x4*)(kwr + i * 8 * KSTR) = kk[J][i]; *(LAS u32x4*)(vwr + i * 8 * 64) = vv[J][i]; } \
        asm volatile("" ::: "memory"); \
        B_PF(J); \
        { const int kr = cu.krlo + t; const int r0q = (qr - 4) < 0 ? 0 : ((qr - 4) > 24 ? 24 : (qr - 4)); const bool rowok = (kr >= r0q) && (kr <= r0q + 7); int dr = kr - qr + 7; dr = dr < 0 ? 0 : (dr > 14 ? 14 : dr); \
          const LAS float* bp = rpb_lds + cu.h * (15 * 64) + dr * 64 + dcb; const float flt = rowok ? fl : 1e9f; \
          f32x16 bb; BLD(0, 0) BLD(1, 1) BLD(2, 2) BLD(3, 3) BLD(4, 8) BLD(5, 9) BLD(6, 10) BLD(7, 11) BLD(8, 16) BLD(9, 17) BLD(10, 18) BLD(11, 19) BLD(12, 24) BLD(13, 25) BLD(14, 26) BLD(15, 27) \
          asm volatile("" : "+v"(bb)); \
          tile_compute<64>(krd, vrd, qf, [=](f32x16& s) { \
              BEL(0, 0) BEL(1, 1) BEL(2, 2) BEL(3, 3) BEL(4, 8) BEL(5, 9) BEL(6, 10) BEL(7, 11) BEL(8, 16) BEL(9, 17) BEL(10, 18) BEL(11, 19) BEL(12, 24) BEL(13, 25) BEL(14, 26) BEL(15, 27) }, o, m, l); } \
        asm volatile("" ::: "memory"); \
        if (++t == cu.nt) { \
            l += __shfl_xor(l, 32); const float inv = frcp(l); bf16_t* prow = B_PROW(cu); \
            _Pragma("unroll") for (int d = 0; d < 2; ++d) _Pragma("unroll") for (int gq = 0; gq < 4; ++gq) { const u32x2 gt = gg[d * 4 + gq]; u32x2 w; \
                w.x = pk2(o[d][4 * gq] * inv * siluf_(bf_lo(gt.x)), o[d][4 * gq + 1] * inv * siluf_(bf_hi(gt.x))); \
                w.y = pk2(o[d][4 * gq + 2] * inv * siluf_(bf_lo(gt.y)), o[d][4 * gq + 3] * inv * siluf_(bf_hi(gt.y))); \
                *(u32x2*)(prow + C_BQ + cu.h * 64 + 32 * d + 8 * gq + 4 * hi) = w; } \
            u += nw; \
            if (u >= nB) done = true; \
            else { cu = b_decode(u); B_LANE(cu); \
                _Pragma("unroll") for (int ks = 0; ks < 4; ++ks) qf[ks] = qn[ks]; \
                B_G(cu); \
                { const int nu = u + nw; if (nu < nB) { const BUnit nb = b_decode(nu); B_Q(nb, qn); } } \
                m = -1e30f; l = 0.f; t = 0; \
                _Pragma("unroll") for (int d = 0; d < 2; ++d) _Pragma("unroll") for (int i = 0; i < 16; ++i) o[d][i] = 0.f; } } } while (0)
#define BLD(i, CF) bb[i] = bp[CF];
#define BEL(i, CF) { const float tt = (float)(CF) + flt; s[i] = (fabsf(tt) <= 7.5f) ? fmaf(s[i], c1, bb[i]) : -1e30f; }
    for (;;) {
        B_STEP(0); if (done) break;
        B_STEP(1); if (done) break;
    }
#undef BEL
#undef BLD
#undef B_STEP
#undef B_Q
#undef B_G
#undef B_LANE
#undef B_PROW
#undef B_PF
}

DI void phase_attn(const Ctx& X0, int chunk, LAS unsigned char* lds, int dry) {
    Ctx X = X0; X.bid = (X0.G % 8 == 0) ? (X0.bid % 8) * (X0.G / 8) + X0.bid / 8 : X0.bid;
    const int tid = X.tid, wave = __builtin_amdgcn_readfirstlane(tid >> 6);
    LAS float* rp = (LAS float*)lds;
    for (int i = tid; i < 8 * 15 * 64; i += 512) { const int col = i & 63, hr = i >> 6;
        rp[i] = (col >= 16 && col <= 46) ? X.in[8][hr * 31 + (col - 16)] * LOG2E : 0.f; }
    __syncthreads();
    LAS unsigned char* vimg = lds + 32768 + wave * 8704;
    const int gw = X.bid * 8 + wave, nw = X.G * 8;
    const int nB = X.ch * 512;
    b_stream_phase(X, vimg, rp, gw, nw, nB);
    __syncthreads();
    { Ctx X2 = X; int t2 = X.tid; asm volatile("" : "+v"(t2)); X2.tid = t2; m_block_phase(X2, chunk, lds); }
    { Ctx X3 = X; int t3 = X.tid; asm volatile("" : "+v"(t3)); X3.tid = t3; a_block_phase(X3, lds); }
    __syncthreads();
}

DI void phase_combine(const Ctx& X, int chunk, int nchunk) {
    const int lane = X.tid & 63, wave = __builtin_amdgcn_readfirstlane(X.tid >> 6);
    const int gw = X.bid * 8 + wave, nw = X.G * 8, ntok = X.ch * SEQ;
    const int h = lane >> 3;
    for (int t0 = gw; t0 < ntok; t0 += 4 * nw) {
        u32x4 a[4], b[4], c[4], gt[4]; float l0[4], l1[4], l2[4];
#pragma unroll
        for (int u = 0; u < 4; ++u) { const int t = (t0 + u * nw < ntok) ? t0 + u * nw : t0; const bf16_t* prow = X.proj + (size_t)t * LDP;
            l0[u] = X.lse[(size_t)t * 24 + h]; l1[u] = X.lse[(size_t)t * 24 + 8 + h]; l2[u] = X.lse[(size_t)t * 24 + 16 + h];
            a[u] = *(const u32x4*)(prow + 8 * lane); b[u] = *(const u32x4*)(prow + 512 + 8 * lane); c[u] = *(const u32x4*)(prow + 1024 + 8 * lane);
            gt[u] = *(const u32x4*)(prow + C_AG + 8 * lane); }
#pragma unroll
        for (int u = 0; u < 4; ++u) { const int t = t0 + u * nw;
            const float mx = fmaxf(l0[u], fmaxf(l1[u], l2[u]));
            float w0 = fexp2(l0[u] - mx), w1 = fexp2(l1[u] - mx), w2 = fexp2(l2[u] - mx);
            const float inv = frcp(w0 + w1 + w2); w0 *= inv; w1 *= inv; w2 *= inv;
            u32x4 w;
#define CMB(f) pk2((w0 * bf_lo(a[u].f) + w1 * bf_lo(b[u].f) + w2 * bf_lo(c[u].f)) * siluf_(bf_lo(gt[u].f)), (w0 * bf_hi(a[u].f) + w1 * bf_hi(b[u].f) + w2 * bf_hi(c[u].f)) * siluf_(bf_hi(gt[u].f)))
            w.x = CMB(x); w.y = CMB(y); w.z = CMB(z); w.w = CMB(w);
#undef CMB
            if (t < ntok) *(u32x4*)(X.proj + (size_t)t * LDP + 8 * lane) = w; }
    }
    if (chunk + 1 < nchunk) rms_tokens(X.in[0], X.in[1], X.in[4], X.hn, (chunk + 1) * ntok, ntok, gw, nw, X.tid);
}

#define XB_TMO      128
#define XB_XCNT(j)  (256  + 64 * (j))
#define XB_XSUB(j)  (1280 + 64 * (j))
#define XB_XGEN(j)  (2304 + 64 * (j))
#define XB_TOP      3328
#define XB_TOPGEN   3392
#define XCD_BAR_WORDS 3456
#define XB_SPIN_CAP (1u << 20)
DI unsigned xb_ld(unsigned* p) { return __hip_atomic_load(p, __ATOMIC_RELAXED, __HIP_MEMORY_SCOPE_AGENT); }
DI unsigned xb_add(unsigned* p, unsigned v) { return __hip_atomic_fetch_add(p, v, __ATOMIC_RELAXED, __HIP_MEMORY_SCOPE_AGENT); }
DI unsigned xb_xcc_id() { return (unsigned)__builtin_amdgcn_s_getreg((3 << 11) | 20) & 0xFu; }
#define XB_SPIN(cond, bar) do { unsigned _sp = 0; while (cond) { __builtin_amdgcn_s_sleep(1); \
    if ((++_sp & 255u) == 0u) { if (xb_ld(&(bar)[XB_TMO])) break; if (_sp > XB_SPIN_CAP) { atomicAdd(&(bar)[XB_TMO], 1u); break; } } } } while (0)
DI void xcd_barrier_complete(unsigned* bar, unsigned x, unsigned& nloc, unsigned& nx) {
    const unsigned G = gridDim.x;
    unsigned sum, cnt, mine, sp = 0u;
    for (;;) {
        sum = 0u; cnt = 0u; mine = 0u;
#pragma unroll
        for (unsigned j = 0; j < 16; ++j) { const unsigned c = xb_ld(&bar[XB_XCNT(j)]); sum += c; cnt += (c > 0u) ? 1u : 0u; mine = (j == x) ? c : mine; }
        if (sum == G) break;
        __builtin_amdgcn_s_sleep(1);
        if ((++sp & 255u) == 0u) { if (xb_ld(&bar[XB_TMO])) break; if (sp > XB_SPIN_CAP) { atomicAdd(&bar[XB_TMO], 1u); break; } }
    }
    nloc = mine > 0u ? mine : 1u; nx = cnt > 0u ? cnt : 1u;
}
DI void xcd_barrier(unsigned* bar, volatile LAS unsigned* st) {
    asm volatile("s_waitcnt vmcnt(0)" ::: "memory");
    __syncthreads();
    if (threadIdx.x == 0) {
        __builtin_amdgcn_s_waitcnt(0);
        const unsigned x = xb_xcc_id();
        unsigned nloc = st[0], nx = st[1];
        if (nloc == 0u) { xcd_barrier_complete(bar, x, nloc, nx); st[0] = nloc; st[1] = nx; }
        const unsigned old = xb_add(&bar[XB_XSUB(x)], 1u);
        const unsigned gen = old / nloc;
        if (old + 1u == (gen + 1u) * nloc) {
            __builtin_amdgcn_fence(__ATOMIC_RELEASE, "agent");
            asm volatile("s_waitcnt vmcnt(0)" ::: "memory");
            const unsigned og = xb_add(&bar[XB_TOP], 1u);
            const unsigned tg = og / nx;
            if (og + 1u == (tg + 1u) * nx) xb_add(&bar[XB_TOPGEN], 1u);
            else XB_SPIN(xb_ld(&bar[XB_TOPGEN]) == tg, bar);
            __builtin_amdgcn_fence(__ATOMIC_ACQUIRE, "agent");
            xb_add(&bar[XB_XGEN(x)], 1u);
            asm volatile("s_waitcnt vmcnt(0)" ::: "memory");
        } else {
            XB_SPIN(xb_ld(&bar[XB_XGEN(x)]) == gen, bar);
            __builtin_amdgcn_fence(__ATOMIC_ACQUIRE, "agent");
            asm volatile("s_waitcnt vmcnt(0)" ::: "memory");
        }
    }
    __syncthreads();
}

__global__ void __launch_bounds__(512, 2) mega(Args a) {
    extern __shared__ __attribute__((aligned(16))) unsigned char lds_raw[];
    LAS unsigned char* lds = (LAS unsigned char*)lds_raw;
    typedef const Args __attribute__((address_space(4))) * KArgP;
    KArgP ap0 = (KArgP)__builtin_amdgcn_kernarg_segment_ptr();
    const int step_lo = ap0->step_lo, step_hi = ap0->step_hi;
    volatile LAS unsigned* bst = (volatile LAS unsigned*)(lds + LDS_PHASE);
    if (threadIdx.x == 0) { bst[0] = 0u; bst[1] = 0u; }
    __syncthreads();
    for (int step = step_lo; step < step_hi; ++step) {
        KArgP ap = ap0; asm volatile("" : "+s"(ap));
        int tid_ = threadIdx.x; asm volatile("" : "+v"(tid_));
        int bid_ = blockIdx.x; asm volatile("" : "+s"(bid_));
        Ctx X;
#pragma unroll
        for (int i = 0; i < 14; ++i) X.in[i] = ap->in[i];
        unsigned char* const ws = ap->ws; const int ch = ap->ch, nchunk = ap->nchunk, coop = ap->coop;
        X.out = ap->out; X.ws = ws; X.ch = ch; X.G = gridDim.x; X.tid = tid_; X.bid = bid_;
        X.win_t = (bf16_t*)(ws + OFF_WIN); X.wkv_t = (bf16_t*)(ws + OFF_WKV); X.wp_t = (bf16_t*)(ws + OFF_WP); X.wout_t = (bf16_t*)(ws + OFF_WOUT);
        X.hn = (bf16_t*)(ws + OFF_DYN); X.memh = (bf16_t*)(ws + OFF_MEMH); X.memkv = (bf16_t*)(ws + OFF_MEMKV); X.ssq = (float*)(ws + OFF_SSQ);
        X.proj = (bf16_t*)(ws + OFF_DYN + hn_bytes(ch)); X.merged = (bf16_t*)(ws + OFF_DYN + hn_bytes(ch) + proj_bytes(ch)); X.lse = (float*)(ws + OFF_DYN + hn_bytes(ch) + proj_bytes(ch) + merged_bytes(ch));
        const int Mc = ch * SEQ;
        bool sync_after = true;
        if (step == 0) {
            if (bid_ == 0) for (int i = tid_; i < XCD_BAR_WORDS + (int)((OFF_DYN - OFF_PCNT) / 4) + (16384 / 4 - XCD_BAR_WORDS); i += 512) __hip_atomic_store((unsigned*)(ws + OFF_CTR) + i, 0u, __ATOMIC_RELAXED, __HIP_MEMORY_SCOPE_AGENT);
            phase_p0(X, lds);
        } else {
            const int chunk = (step - 1) / 5, k = (step - 1) % 5;
            if (k == 0) {
                if (chunk == 0) {
                    pg8::Gemm g{X.memh, X.wkv_t, DM, DM, DM, 0, 0, 0, 0}; pg8::StaticOrder S; S.init(NSEQ * NMEM, DM, 1, X.G, X.bid);
                    pg8::EpiBf16 E{X.memkv, DM};
                    pg8::gemm_phase<pg8::EpiBf16, pg8::StaticOrder>(lds, g, S, E, X.tid);
                }
                pg8::Gemm g{X.hn, X.win_t, DM, DM, DM, 0, 0, 0, 0}; pg8::StaticOrder S; S.init(Mc, DIN, 1, X.G, X.bid, P1_WGM);
                pg8::EpiBf16 E{X.proj, LDP};
#if PROBE == 1
                for (int rep = 0; rep < 2; ++rep)
#endif
                pg8::gemm_phase<pg8::EpiBf16, pg8::StaticOrder>(lds, g, S, E, X.tid);
            } else if (k == 1) {
#if PROBE == 2
                for (int rep = 0; rep < 2; ++rep) { int dry = 1 - rep; asm volatile("" : "+s"(dry)); phase_attn(X, chunk, lds, dry); }
#else
                phase_attn(X, chunk, lds, 0);
#endif
            } else if (k == 2) {
                phase_combine(X, chunk, nchunk);
            } else if (k == 3) {
                pg8::Gemm g{X.proj, X.wp_t, 512, LDP, 512, C_AQ, C_BQ, C_MQ, (size_t)1024 * 512}; pg8::StaticOrder S; S.init(Mc, DM, 3, X.G, X.bid);
                pg8::EpiGate E{X.proj, X.merged};
#if PROBE == 6
                { pg8::EpiBf16 E0{X.merged, DM}; pg8::gemm_phase<pg8::EpiBf16, pg8::StaticOrder>(lds, g, S, E0, X.tid); }
#endif
#if PROBE == 3
                for (int rep = 0; rep < 2; ++rep)
#endif
                pg8::gemm_phase<pg8::EpiGate, pg8::StaticOrder>(lds, g, S, E, X.tid);
            } else {
                pg8::Gemm g{X.merged, X.wout_t, DM, DM, DM, 0, 0, 0, 0}; pg8::StaticOrder S; S.init(Mc, DM, 1, X.G, X.bid);
                pg8::EpiOut E{X.in[0], X.in[1], X.out, X.ssq, (unsigned*)(ws + OFF_PCNT), X.in[13], chunk * Mc, lds + 131072};
#if PROBE == 4
                for (int rep = 0; rep < 2; ++rep)
#endif
                pg8::gemm_phase<pg8::EpiOut, pg8::StaticOrder>(lds, g, S, E, X.tid);
                if (chunk + 1 < nchunk) sync_after = false;
            }
        }
        if (coop && sync_after && step + 1 < step_hi) {
            if (step == 0) { cg::this_grid().sync();
                if (threadIdx.x == 0) (void)xb_add((unsigned*)(ws + OFF_CTR) + XB_XCNT(xb_xcc_id()), 1u); }
            else xcd_barrier((unsigned*)(ws + OFF_CTR), bst);
        }
    }
}

extern "C" void kernel_launch(void* const* d_in, const int* in_sizes, int n_in, void* d_out, int out_size, void* d_ws, size_t ws_size, hipStream_t stream) {
    static int grid = 0, ch = 0, coop = 1;
    if (grid == 0) {
        int dev = 0, cus = 0, per_cu = 0;
        if (hipGetDevice(&dev) != hipSuccess || hipDeviceGetAttribute(&cus, hipDeviceAttributeMultiprocessorCount, dev) != hipSuccess) { fprintf(stderr, "kernel_launch: device query failed\n"); grid = -1; return; }
        if (hipFuncSetAttribute((const void*)mega, hipFuncAttributeMaxDynamicSharedMemorySize, LDS_BYTES) != hipSuccess) { fprintf(stderr, "kernel_launch: hipFuncSetAttribute failed\n"); grid = -1; return; }
        if (hipOccupancyMaxActiveBlocksPerMultiprocessor(&per_cu, (const void*)mega, 512, LDS_BYTES) != hipSuccess || per_cu < 1) { fprintf(stderr, "kernel_launch: occupancy query says %d\n", per_cu); per_cu = 1; }
        (void)hipGetLastError();
        grid = cus * 1;
        const int cands[8] = {16, 8, 6, 4, 3, 2, 1, 1};
        for (int i = 0; i < 8; ++i) if (ws_needed(cands[i]) <= ws_size) { ch = cands[i]; break; }
        if (ch == 0) { fprintf(stderr, "kernel_launch: workspace too small (%zu)\n", ws_size); grid = -1; return; }
        fprintf(stderr, "kernel_launch: grid %d, per_cu %d, ch %d, ws %zu\n", grid, per_cu, ch, ws_size);
    }
    if (grid < 0) return;
    Args a{};
    for (int i = 0; i < 14; ++i) a.in[i] = (const float*)d_in[i];
    a.out = (float*)d_out; a.ws = (unsigned char*)d_ws; a.ch = ch; a.nchunk = NSEQ / ch; a.pad = 0;
    const int nsteps = 1 + 5 * a.nchunk;
    if (coop) {
        a.step_lo = 0; a.step_hi = nsteps; a.coop = 1;
        void* args[] = {&a};
        hipError_t e = hipLaunchCooperativeKernel((const void*)mega, dim3(grid), dim3(512), args, LDS_BYTES, stream);
        if (e == hipSuccess) return;
        fprintf(stderr, "kernel_launch: cooperative launch failed: %s; falling back to one launch per phase\n", hipGetErrorString(e));
        (void)hipGetLastError();
        coop = 0;
    }
    for (int s = 0; s < nsteps; ++s) {
        a.step_lo = s; a.step_hi = s + 1; a.coop = 0;
        hipLaunchKernelGGL(mega, dim3(grid), dim3(512), LDS_BYTES, stream, a);
    }
}
```
